# Optimizing an MI355X kernel written in HIP

```python
import jax, jax.numpy as jnp
from jax import lax
import numpy as np

D_MODEL = 1024
BATCH = 8
SEQ = 8192
DEPTH = 2
DEC_BATCH = 16
DEC_SEQ = 4096
PAST_LEN = 128

HEAD_DIM = 64
N_Q_HEADS = 8
N_KV_HEADS = 2
Q_PER_KV = N_Q_HEADS // N_KV_HEADS
ATTN_WIDTH = N_Q_HEADS * HEAD_DIM
KV_WIDTH = N_KV_HEADS * HEAD_DIM
CONV_GROUPS = 8
CONV_WIDTH = CONV_GROUPS * HEAD_DIM
CONV_K = 3
MIX_WIDTH = ATTN_WIDTH + CONV_WIDTH
IN_PROJ_WIDTH = ATTN_WIDTH + 2 * KV_WIDTH + 3 * CONV_WIDTH
D_FF = ((8 * D_MODEL // 3 + 255) // 256) * 256
GRID_W = 64
ROPE_THETA = 10000.0
ROPE_PAIRS_PER_AXIS = HEAD_DIM // 4
Q_BLOCK = 128
N_MOD = 6
EPS = 1e-6

kernel_name = "hymba_attn_shortconv_adaln_encoder"


def rmsnorm(x, g):
    xf = x.astype(jnp.float32)
    y = xf * lax.rsqrt(jnp.mean(xf * xf, axis=-1, keepdims=True) + EPS)
    return (y * g.astype(jnp.float32)).astype(x.dtype)


def axial_rotary_tables(S):
    rows = S // GRID_W
    row = jnp.repeat(jnp.arange(rows, dtype=jnp.float32), GRID_W)
    col = jnp.tile(jnp.arange(GRID_W, dtype=jnp.float32), rows)
    inv = ROPE_THETA ** (-jnp.arange(ROPE_PAIRS_PER_AXIS, dtype=jnp.float32) / ROPE_PAIRS_PER_AXIS)
    ang = jnp.concatenate([row[:, None] * inv, col[:, None] * inv], axis=-1)
    return jnp.cos(ang), jnp.sin(ang)


def apply_rotary(x, cos, sin):
    B, S, H, D = x.shape
    xp = x.astype(jnp.float32).reshape(B, S, H, D // 2, 2)
    x0, x1 = xp[..., 0], xp[..., 1]
    c = cos[None, :, None, :]
    s = sin[None, :, None, :]
    out = jnp.stack([x0 * c - x1 * s, x0 * s + x1 * c], axis=-1)
    return out.reshape(B, S, H, D).astype(x.dtype)


def gqa_bidirectional(q, k, v):
    B, S, _, _ = q.shape
    nblk = S // Q_BLOCK
    scale = HEAD_DIM ** -0.5
    qb = q.reshape(B, nblk, Q_BLOCK, N_KV_HEADS, Q_PER_KV, HEAD_DIM).transpose(1, 0, 2, 3, 4, 5)

    def block(qblk):
        s = jnp.einsum("bqkgd,bskd->bkgqs", qblk, k).astype(jnp.float32) * scale
        p = jax.nn.softmax(s, axis=-1)
        return jnp.einsum("bkgqs,bskd->bqkgd", p.astype(v.dtype), v)

    o = lax.map(block, qb)
    return o.transpose(1, 0, 2, 3, 4, 5).reshape(B, S, ATTN_WIDTH)


def centred_short_conv(u, w):
    up = jnp.pad(u, ((0, 0), (1, 1), (0, 0)))
    return up[:, :-2] * w[0] + up[:, 1:-1] * w[1] + up[:, 2:] * w[2]


def encoder_layer(x, c, w_mod, b_mod, g_mix, w_in, q_gain, k_gain, conv_w, w_out,
                  g_ffn, w_gate, w_up, w_down):
    B, S, _ = x.shape
    mod = (jax.nn.silu(c) @ w_mod + b_mod)[:, None, :]
    shift1, scale1, gate1, shift2, scale2, gate2 = jnp.split(mod, N_MOD, axis=-1)

    h = rmsnorm(x, g_mix) * (1 + scale1) + shift1
    proj = h @ w_in
    splits = np.cumsum([ATTN_WIDTH, KV_WIDTH, KV_WIDTH, CONV_WIDTH, CONV_WIDTH]).tolist()
    q, k, v, gb, gc, u = jnp.split(proj, splits, axis=-1)

    cos, sin = axial_rotary_tables(S)
    q = rmsnorm(q.reshape(B, S, N_Q_HEADS, HEAD_DIM), q_gain)
    k = rmsnorm(k.reshape(B, S, N_KV_HEADS, HEAD_DIM), k_gain)
    q = apply_rotary(q, cos, sin)
    k = apply_rotary(k, cos, sin)
    v = v.reshape(B, S, N_KV_HEADS, HEAD_DIM)
    attn = gqa_bidirectional(q, k, v)

    conv = gb * centred_short_conv(gc * u, conv_w)

    x = x + gate1 * (jnp.concatenate([attn, conv], axis=-1) @ w_out)

    h = rmsnorm(x, g_ffn) * (1 + scale2) + shift2
    f = (jax.nn.silu(h @ w_gate) * (h @ w_up)) @ w_down
    return x + gate2 * f


def setup_inputs(seed: int = 0) -> dict:
    key = jax.random.key(seed)
    ks = jax.random.split(key, 20)
    f32 = jnp.float32
    D = D_MODEL

    def nrm(k, shape, scale):
        return jax.random.normal(k, shape, f32) * scale

    return {
        "x_prompt": nrm(ks[0], (BATCH, SEQ, D), 1.0),
        "x_sample": nrm(ks[1], (DEC_BATCH, DEC_SEQ, D), 1.0),
        "c_prompt": nrm(ks[2], (BATCH, D), 1.0),
        "c_sample": nrm(ks[3], (DEC_BATCH, D), 1.0),
        "w_mod": nrm(ks[4], (DEPTH, D, N_MOD * D), D ** -0.5),
        "b_mod": nrm(ks[5], (DEPTH, N_MOD * D), 0.01),
        "g_mix": 1.0 + nrm(ks[6], (DEPTH, D), 0.01),
        "w_in": nrm(ks[7], (DEPTH, D, IN_PROJ_WIDTH), D ** -0.5),
        "q_gain": 1.0 + nrm(ks[8], (DEPTH, HEAD_DIM), 0.01),
        "k_gain": 1.0 + nrm(ks[9], (DEPTH, HEAD_DIM), 0.01),
        "conv_w": nrm(ks[10], (DEPTH, CONV_K, CONV_WIDTH), CONV_K ** -0.5),
        "w_out": nrm(ks[11], (DEPTH, MIX_WIDTH, D), MIX_WIDTH ** -0.5),
        "g_ffn": 1.0 + nrm(ks[12], (DEPTH, D), 0.01),
        "w_gate": nrm(ks[13], (DEPTH, D, D_FF), D ** -0.5),
        "w_up": nrm(ks[14], (DEPTH, D, D_FF), D ** -0.5),
        "w_down": nrm(ks[15], (DEPTH, D_FF, D), D_FF ** -0.5),
        "g_final": 1.0 + nrm(ks[16], (D,), 0.01),
    }


def reference(x_prompt, x_sample, c_prompt, c_sample, w_mod, b_mod, g_mix, w_in, q_gain,
              k_gain, conv_w, w_out, g_ffn, w_gate, w_up, w_down, g_final):
    hp = x_prompt
    hs = x_sample
    for l in range(DEPTH):
        hp = encoder_layer(hp, c_prompt, w_mod[l], b_mod[l], g_mix[l], w_in[l], q_gain[l],
                           k_gain[l], conv_w[l], w_out[l], g_ffn[l], w_gate[l], w_up[l], w_down[l])
        hs = encoder_layer(hs, c_sample, w_mod[l], b_mod[l], g_mix[l], w_in[l], q_gain[l],
                           k_gain[l], conv_w[l], w_out[l], g_ffn[l], w_gate[l], w_up[l], w_down[l])
    y_prompt = rmsnorm(hp, g_final)
    y_sample = rmsnorm(hs, g_final)
    return (y_prompt, y_sample)
```

```cpp
#include <hip/hip_runtime.h>
#include <hip/hip_cooperative_groups.h>
#include <hip/hip_bf16.h>
#include <cstdio>
#include <cstdint>
#include <cmath>
namespace cg = cooperative_groups;
namespace pg8 {
#define PG8_LAS __attribute__((address_space(3)))
typedef unsigned short bf16_t;
typedef short bf16x8 __attribute__((ext_vector_type(8)));
typedef float f32x4 __attribute__((ext_vector_type(4)));
typedef unsigned u32x4 __attribute__((ext_vector_type(4)));
constexpr int BM = 256, BK = 64, HALF = 128, HTB = HALF * BK * 2  , STAGE_BYTES = 8 * HTB, NXCD = 8, WGM = 8;

__host__ __device__ __forceinline__ int lds_byte(int r, int c) { const int st = (r >> 4) * 2 + (c >> 5), rr = r & 15, cc = c & 31, ob = rr * 64 + cc * 2; return st * 1024 + (ob ^ (((ob >> 9) & 1) << 5)); }
__host__ __device__ __forceinline__ void stage_rc(int b, int& R, int& C) { const int st = b / 1024, sb = b % 1024, swz = sb ^ (((sb >> 9) & 1) << 5); R = (st >> 1) * 16 + swz / 64; C = (st & 1) * 32 + (swz % 64) / 2; }
__host__ __device__ __forceinline__ int perm32(int rho) { const int n = rho >> 4, i = rho & 15; return 8 * (i >> 2) + 4 * n + (i & 3); }

struct Unit { int pm, pn, pa; };
struct Gemm { const bf16_t* A; const bf16_t* Bt; int M, N, K; };

struct StaticOrder {
    int nM, nN, nwg, G, c, rev;
    __host__ __device__ void init(int M, int N, int G_, int c_, int rev_ = 0) { nM = M / BM; nN = N / BM; nwg = nM * nN; G = G_; c = c_; rev = rev_; }
    __host__ __device__ bool next(int i, Unit& u) const {
        const long L = (long)i * G + c; if (L >= nwg) return false;
        int wgid = (int)L; { const int q = nwg / NXCD, r = nwg % NXCD, xcd = wgid % NXCD, off = wgid / NXCD; wgid = (xcd < r ? xcd * (q + 1) : r * (q + 1) + (xcd - r) * q) + off; }
        const int nig = WGM * nN, gid = wgid / nig, fm = gid * WGM, gsz = (nM - fm) < WGM ? (nM - fm) : WGM;
        u.pm = fm + ((wgid % nig) % gsz); u.pn = (wgid % nig) / gsz; if (rev) u.pm = nM - 1 - u.pm; u.pa = u.pm; return true;
    }
    __device__ __forceinline__ void a_ready(const Unit&) const {}
    __device__ __forceinline__ void done(const Unit&) const {}
};

__device__ __forceinline__ unsigned cvt_pk_bf16(float lo, float hi) { unsigned r; asm volatile("v_cvt_pk_bf16_f32 %0, %1, %2" : "=v"(r) : "v"(lo), "v"(hi)); return r; }
typedef float f32x2 __attribute__((ext_vector_type(2)));
constexpr size_t PMiB = 1u << 20, PWS_ROT = 0, PWS_F = 308 * PMiB, TEAM_SLICE = (size_t)16384 * 2816 * 2, TS_Q = 0, TS_K = 16 * PMiB, TS_V = 20 * PMiB, TS_BG = 24 * PMiB, TS_CU = 40 * PMiB;
static_assert(TS_CU + 16 * PMiB <= TEAM_SLICE, "team slice");
__host__ __device__ __forceinline__ int team_of_tile(int pm) { return pm < 256 ? pm >> 5 : (pm - 256) >> 5; }
__host__ __device__ __forceinline__ int local_tile(int pm) { return pm < 256 ? pm & 31 : 32 + ((pm - 256) & 31); }
constexpr float QK_EPS = 1e-6f;
constexpr float ATT_C2 = 0.125f * 1.4426950408889634f;

struct EpiProj {
    static constexpr bool PERM = true, AFTER_DRAIN = false;
    unsigned char* ws; const float* qg; const float* kg;
    __device__ __forceinline__ void operator()(const f32x4 (&acc)[2][2][4][2], const Unit& u, int wr, int wc, int fr, int fq) const {
        const int pn = u.pn; const int grow0 = u.pm * BM + wr * 64 + fr;
        const int row0 = local_tile(u.pm) * BM + wr * 64 + fr;
        unsigned char* const sl = ws + PWS_F + (size_t)team_of_tile(u.pm) * TEAM_SLICE;
        bf16_t* const Q = (bf16_t*)(sl + TS_Q); bf16_t* const Kb = (bf16_t*)(sl + TS_K); bf16_t* const Vb = (bf16_t*)(sl + TS_V); bf16_t* const Bg = (bf16_t*)(sl + TS_BG); bf16_t* const CU = (bf16_t*)(sl + TS_CU); const float* const rot = (const float*)(ws + PWS_ROT);
        if (pn >= 5) {
            bf16_t* base = CU + (size_t)row0 * 512 + (pn - 5) * 128 + wc * 32 + fq * 8;
#pragma unroll
            for (int ai = 0; ai < 2; ++ai)
#pragma unroll
                for (int m = 0; m < 4; ++m) { const f32x4 v0 = acc[ai][0][m][0] * acc[ai][1][m][0], v1 = acc[ai][0][m][1] * acc[ai][1][m][1];
                    u32x4 w; w.x = cvt_pk_bf16(v0[0], v0[1]); w.y = cvt_pk_bf16(v0[2], v0[3]); w.z = cvt_pk_bf16(v1[0], v1[1]); w.w = cvt_pk_bf16(v1[2], v1[3]);
                    *(u32x4*)(base + (size_t)(ai * HALF + m * 16) * 512) = w; }
            return;
        }
        const bool is_q = pn < 2, is_k = (pn == 2) && (wc < 2), is_v = (pn == 2) && (wc >= 2);
        bf16_t* base; int pitch;
        if (is_q) { base = Q + pn * 256 + wc * 64; pitch = 512; }
        else if (is_k) { base = Kb + wc * 64; pitch = 128; }
        else if (is_v) { base = Vb + (wc - 2) * 64; pitch = 128; }
        else { base = Bg + (pn - 3) * 256 + wc * 64; pitch = 512; }
        base += (size_t)row0 * pitch + fq * 8;
        if (is_q || is_k) {
            const float* gp = (is_q ? qg : kg) + fq * 8; const float osc = is_q ? ATT_C2 : 1.0f;
            f32x4 gv[2][2];
#pragma unroll
            for (int bj = 0; bj < 2; ++bj)
#pragma unroll
                for (int n = 0; n < 2; ++n) gv[bj][n] = *(const f32x4*)(gp + bj * 32 + n * 4) * osc;
#pragma unroll
            for (int ai = 0; ai < 2; ++ai)
#pragma unroll
                for (int m = 0; m < 4; ++m) {
                    float ss = 0.f;
#pragma unroll
                    for (int bj = 0; bj < 2; ++bj)
#pragma unroll
                        for (int n = 0; n < 2; ++n) { const f32x4 x = acc[ai][bj][m][n]; ss += (x[0] * x[0] + x[1] * x[1]) + (x[2] * x[2] + x[3] * x[3]); }
                    ss += __shfl_xor(ss, 16); ss += __shfl_xor(ss, 32);
                    const float rstd = __builtin_amdgcn_rsqf(ss * (1.0f / 64.0f) + QK_EPS);
                    const int t = grow0 + ai * HALF + m * 16;
                    const int prow = (t < 65536) ? ((t >> 6) & 127) : ((t >> 6) & 63), pcol = t & 63;
#pragma unroll
                    for (int bj = 0; bj < 2; ++bj) {
                        const float* rp = rot + ((bj ? pcol : prow) * 16 + fq * 4) * 2;
                        f32x4 o[2];
#pragma unroll
                        for (int n = 0; n < 2; ++n) { const f32x4 cs = *(const f32x4*)(rp + n * 4); const f32x4 x = acc[ai][bj][m][n] * rstd * gv[bj][n];
                            o[n][0] = x[0] * cs[0] - x[1] * cs[1]; o[n][1] = x[0] * cs[1] + x[1] * cs[0]; o[n][2] = x[2] * cs[2] - x[3] * cs[3]; o[n][3] = x[2] * cs[3] + x[3] * cs[2]; }
                        u32x4 w; w.x = cvt_pk_bf16(o[0][0], o[0][1]); w.y = cvt_pk_bf16(o[0][2], o[0][3]); w.z = cvt_pk_bf16(o[1][0], o[1][1]); w.w = cvt_pk_bf16(o[1][2], o[1][3]);
                        *(u32x4*)(base + (size_t)(ai * HALF + m * 16) * pitch + bj * 32) = w; }
                }
        } else {
#pragma unroll
            for (int ai = 0; ai < 2; ++ai)
#pragma unroll
                for (int m = 0; m < 4; ++m)
#pragma unroll
                    for (int bj = 0; bj < 2; ++bj) { const f32x4 v0 = acc[ai][bj][m][0], v1 = acc[ai][bj][m][1];
                        u32x4 w; w.x = cvt_pk_bf16(v0[0], v0[1]); w.y = cvt_pk_bf16(v0[2], v0[3]); w.z = cvt_pk_bf16(v1[0], v1[1]); w.w = cvt_pk_bf16(v1[2], v1[3]);
                        *(u32x4*)(base + (size_t)(ai * HALF + m * 16) * pitch + bj * 32) = w; }
        }
    }
};
struct EpiResid {
    static constexpr bool PERM = true, AFTER_DRAIN = false;
    const float* xa; const float* xb; bf16_t* res; const float* gate; int in_f32;
    __device__ __forceinline__ void operator()(const f32x4 (&acc)[2][2][4][2], const Unit& u, int wr, int wc, int fr, int fq) const {
        const int rowt = u.pm * BM; const int b = rowt < 65536 ? (rowt >> 13) : 8 + ((rowt - 65536) >> 12);
        const float* xin = rowt < 65536 ? xa : xb;
        const int row0 = rowt + wr * 64 + fr, col0 = u.pn * BM + wc * 32 + fq * 8;
        f32x4 gv[2][2];
#pragma unroll
        for (int bj = 0; bj < 2; ++bj)
#pragma unroll
            for (int n = 0; n < 2; ++n) gv[bj][n] = *(const f32x4*)(gate + (size_t)b * 6144 + col0 + bj * HALF + n * 4);
        if (in_f32) {
#pragma unroll
            for (int ai = 0; ai < 2; ++ai)
#pragma unroll
                for (int mp = 0; mp < 2; ++mp) { f32x4 x[2][2][2];
#pragma unroll
                    for (int mm = 0; mm < 2; ++mm)
#pragma unroll
                        for (int bj = 0; bj < 2; ++bj) { const float* p = xin + (size_t)(row0 + ai * HALF + (2 * mp + mm) * 16) * 1024 + col0 + bj * HALF; x[mm][bj][0] = *(const f32x4*)p; x[mm][bj][1] = *(const f32x4*)(p + 4); }
#pragma unroll
                    for (int mm = 0; mm < 2; ++mm)
#pragma unroll
                        for (int bj = 0; bj < 2; ++bj) { const int m = 2 * mp + mm; const f32x4 y0 = x[mm][bj][0] + gv[bj][0] * acc[ai][bj][m][0], y1 = x[mm][bj][1] + gv[bj][1] * acc[ai][bj][m][1];
                            u32x4 w; w.x = cvt_pk_bf16(y0[0], y0[1]); w.y = cvt_pk_bf16(y0[2], y0[3]); w.z = cvt_pk_bf16(y1[0], y1[1]); w.w = cvt_pk_bf16(y1[2], y1[3]);
                            *(u32x4*)(res + (size_t)(row0 + ai * HALF + m * 16) * 2048 + col0 + bj * HALF) = w; }
                    asm volatile("" ::: "memory"); }
        } else {
#pragma unroll
            for (int ai = 0; ai < 2; ++ai) { u32x4 p[4][2];
#pragma unroll
                for (int m = 0; m < 4; ++m)
#pragma unroll
                    for (int bj = 0; bj < 2; ++bj) p[m][bj] = *(const u32x4*)(res + (size_t)(row0 + ai * HALF + m * 16) * 2048 + col0 + bj * HALF);
#pragma unroll
                for (int m = 0; m < 4; ++m)
#pragma unroll
                    for (int bj = 0; bj < 2; ++bj) { const u32x4 q = p[m][bj];
                        const f32x4 x0 = (f32x4){__uint_as_float(q.x << 16), __uint_as_float(q.x & 0xffff0000u), __uint_as_float(q.y << 16), __uint_as_float(q.y & 0xffff0000u)};
                        const f32x4 x1 = (f32x4){__uint_as_float(q.z << 16), __uint_as_float(q.z & 0xffff0000u), __uint_as_float(q.w << 16), __uint_as_float(q.w & 0xffff0000u)};
                        const f32x4 y0 = x0 + gv[bj][0] * acc[ai][bj][m][0], y1 = x1 + gv[bj][1] * acc[ai][bj][m][1];
                        u32x4 w; w.x = cvt_pk_bf16(y0[0], y0[1]); w.y = cvt_pk_bf16(y0[2], y0[3]); w.z = cvt_pk_bf16(y1[0], y1[1]); w.w = cvt_pk_bf16(y1[2], y1[3]);
                        *(u32x4*)(res + (size_t)(row0 + ai * HALF + m * 16) * 2048 + col0 + bj * HALF) = w; }
                asm volatile("" ::: "memory"); }
        }
    }
};
struct EpiSwiglu {
    static constexpr bool PERM = true, AFTER_DRAIN = false;
    unsigned char* ws;
    __device__ __forceinline__ void operator()(const f32x4 (&acc)[2][2][4][2], const Unit& u, int wr, int wc, int fr, int fq) const {
        bf16_t* base = (bf16_t*)(ws + PWS_F + (size_t)team_of_tile(u.pm) * TEAM_SLICE) + (size_t)(local_tile(u.pm) * BM + wr * 64 + fr) * 2816 + u.pn * 128 + wc * 32 + fq * 8;
#pragma unroll
        for (int ai = 0; ai < 2; ++ai)
#pragma unroll
            for (int m = 0; m < 4; ++m) { f32x4 o[2];
#pragma unroll
                for (int n = 0; n < 2; ++n) { const f32x4 g = acc[ai][0][m][n], up = acc[ai][1][m][n];
#pragma unroll
                    for (int e = 0; e < 4; ++e) { const float ex = __builtin_amdgcn_exp2f(g[e] * -1.4426950408889634f); o[n][e] = g[e] * __builtin_amdgcn_rcpf(1.0f + ex) * up[e]; } }
                u32x4 w; w.x = cvt_pk_bf16(o[0][0], o[0][1]); w.y = cvt_pk_bf16(o[0][2], o[0][3]); w.z = cvt_pk_bf16(o[1][0], o[1][1]); w.w = cvt_pk_bf16(o[1][2], o[1][3]);
                *(u32x4*)(base + (size_t)(ai * HALF + m * 16) * 2816) = w; }
    }
};
template <class Epi, class Sched, bool ALIGN_EPI = false, bool SP2 = false>
__device__ __forceinline__ void gemm_phase(PG8_LAS unsigned char* lds, const Gemm g, const Sched& S, const Epi& E) {
    int tid_l = threadIdx.x; asm volatile("" : "+v"(tid_l));
    const int tid = tid_l, wid = __builtin_amdgcn_readfirstlane(tid >> 6), lane = tid & 63, wr = wid >> 2, wc = wid & 3, fr = lane & 15, fq = lane >> 4;
    const int K = g.K, nt = K / BK;
    unsigned voffA[2], voffB[2];
#pragma unroll
    for (int i = 0; i < 2; ++i) { int R, C; stage_rc(tid * 16 + i * 8192, R, C); const int Rb = Epi::PERM ? ((R & ~31) + perm32(R & 31)) : R;
        voffA[i] = (unsigned)(R * K + C) * 2u; voffB[i] = (unsigned)(Rb * K + C) * 2u; }
    const size_t kstep = (size_t)(BK * 2);
    const size_t hstep = (size_t)HALF * K * 2;
    const size_t tstep = 2 * hstep;
    const unsigned ldsw = (unsigned)wid * 1024u;
    const int aoff = lds_byte(wr * 64 + fr, fq * 8), boff = lds_byte(wc * 32 + fr, fq * 8);
#define PG8_SA(b, h) (((b) * 2 + (h)) * HTB)
#define PG8_SB(b, h) ((4 + (b) * 2 + (h)) * HTB)
#define PG8_STAGE(bufoff, gbase, voff) do { _Pragma("unroll") for (int _i = 0; _i < 2; ++_i) \
        __builtin_amdgcn_global_load_lds((const unsigned*)((const char*)(gbase) + (voff)[_i]), (PG8_LAS unsigned*)(lds + (bufoff) + ldsw + _i * 8192), 16, 0, 0); } while (0)
#define PG8_LDA(dst, b, h) do { _Pragma("unroll") for (int m = 0; m < 4; ++m) _Pragma("unroll") for (int k = 0; k < 2; ++k) dst[m][k] = *(const PG8_LAS bf16x8*)(lds + PG8_SA(b, h) + aoff + m * 2048 + k * 1024); } while (0)
#define PG8_LDB(dst, b, h) do { _Pragma("unroll") for (int n = 0; n < 2; ++n) _Pragma("unroll") for (int k = 0; k < 2; ++k) dst[n][k] = *(const PG8_LAS bf16x8*)(lds + PG8_SB(b, h) + boff + n * 2048 + k * 1024); } while (0)
#define PG8_MMA(ai, bj, At, Bt) do { __builtin_amdgcn_s_setprio(1); _Pragma("unroll") for (int m = 0; m < 4; ++m) _Pragma("unroll") for (int n = 0; n < 2; ++n) _Pragma("unroll") for (int k = 0; k < 2; ++k) \
        acc[ai][bj][m][n] = __builtin_amdgcn_mfma_f32_16x16x32_bf16(Bt[n][k], At[m][k], acc[ai][bj][m][n], 0, 0, 0); __builtin_amdgcn_s_setprio(0); } while (0)
#define PG8_WAIT_V(n) asm volatile("s_waitcnt vmcnt(" #n ")" ::: "memory")
#define PG8_WAIT_L(n) asm volatile("s_waitcnt lgkmcnt(" #n ")" ::: "memory")
#define PG8_BAR __builtin_amdgcn_s_barrier()
#define PG8_SCHED __builtin_amdgcn_sched_barrier(0)
    Unit cur, nxt; int ui = 0;
    if (!S.next(0, cur)) return;
    f32x4 acc[2][2][4][2];
#pragma unroll
    for (int a = 0; a < 2; ++a)
#pragma unroll
        for (int b = 0; b < 2; ++b)
#pragma unroll
            for (int m = 0; m < 4; ++m)
#pragma unroll
                for (int n = 0; n < 2; ++n) acc[a][b][m][n] = (f32x4){0.f, 0.f, 0.f, 0.f};
    bf16x8 At[4][2], B0[2][2], B1[2][2];
    const char* cA = (const char*)g.A + (size_t)cur.pa * tstep; const char* cB = (const char*)g.Bt + (size_t)cur.pn * tstep;
    S.a_ready(cur);
    if constexpr (SP2) {
        PG8_STAGE(PG8_SB(0, 0), cB, voffB); PG8_STAGE(PG8_SB(0, 1), cB + hstep, voffB); PG8_STAGE(PG8_SA(0, 0), cA, voffA); PG8_STAGE(PG8_SA(0, 1), cA + hstep, voffA);
        if (wr == 1) PG8_BAR;
        PG8_WAIT_V(2); PG8_BAR;
        PG8_STAGE(PG8_SB(1, 0), cB + kstep, voffB); PG8_STAGE(PG8_SA(1, 0), cA + kstep, voffA); PG8_STAGE(PG8_SB(1, 1), cB + hstep + kstep, voffB);
        PG8_WAIT_V(6); PG8_BAR;
    } else {
        PG8_STAGE(PG8_SB(0, 0), cB, voffB); PG8_STAGE(PG8_SA(0, 0), cA, voffA); PG8_STAGE(PG8_SB(0, 1), cB + hstep, voffB); PG8_STAGE(PG8_SA(0, 1), cA + hstep, voffA);
        if (wr == 1) PG8_BAR;
        PG8_WAIT_V(4); PG8_BAR;
        PG8_STAGE(PG8_SB(1, 0), cB + kstep, voffB); PG8_STAGE(PG8_SA(1, 0), cA + kstep, voffA); PG8_STAGE(PG8_SB(1, 1), cB + hstep + kstep, voffB);
        PG8_WAIT_V(6); PG8_BAR;
    }
    for (;;) {
        const bool has_next = S.next(ui + 1, nxt);
        const char* nA = has_next ? (const char*)g.A + (size_t)nxt.pa * tstep : cA; const char* nB = has_next ? (const char*)g.Bt + (size_t)nxt.pn * tstep : cB;
        for (int t = 0; t < nt; t += 2) {
            const bool last = (t == nt - 2);
            const char* a1 = cA + (size_t)(t + 1) * kstep;
            const char* a2 = last ? nA : cA + (size_t)(t + 2) * kstep; const char* b2 = last ? nB : cB + (size_t)(t + 2) * kstep;
            const char* a3 = a2 + kstep; const char* b3 = b2 + kstep;
            if (last && has_next) S.a_ready(nxt);
            if constexpr (SP2) {
            PG8_LDB(B0, 0, 0); PG8_LDB(B1, 0, 1); PG8_SCHED; PG8_LDA(At, 0, 0); PG8_STAGE(PG8_SA(1, 1), a1 + hstep, voffA);
            PG8_WAIT_V(8); PG8_WAIT_L(0); PG8_BAR; PG8_MMA(0, 0, At, B0); PG8_MMA(0, 1, At, B1); PG8_BAR; PG8_SCHED;
            PG8_LDA(At, 0, 1); PG8_STAGE(PG8_SB(0, 0), b2, voffB); PG8_STAGE(PG8_SB(0, 1), b2 + hstep, voffB); PG8_STAGE(PG8_SA(0, 0), a2, voffA);
            PG8_WAIT_V(8); PG8_WAIT_L(0); PG8_BAR; PG8_MMA(1, 0, At, B0); PG8_MMA(1, 1, At, B1); PG8_BAR; PG8_SCHED;
            PG8_LDB(B0, 1, 0); PG8_LDB(B1, 1, 1); PG8_SCHED; PG8_LDA(At, 1, 0); PG8_STAGE(PG8_SA(0, 1), a2 + hstep, voffA);
            PG8_WAIT_V(8); PG8_WAIT_L(0); PG8_BAR; PG8_MMA(0, 0, At, B0); PG8_MMA(0, 1, At, B1); PG8_BAR; PG8_SCHED;
            PG8_LDA(At, 1, 1); PG8_STAGE(PG8_SB(1, 0), b3, voffB); PG8_STAGE(PG8_SB(1, 1), b3 + hstep, voffB); PG8_STAGE(PG8_SA(1, 0), a3, voffA);
            PG8_WAIT_V(8); PG8_WAIT_L(0); PG8_BAR; PG8_MMA(1, 0, At, B0); PG8_MMA(1, 1, At, B1); PG8_BAR; PG8_SCHED;
            } else {
            PG8_LDB(B0, 0, 0); PG8_SCHED; PG8_LDA(At, 0, 0); PG8_STAGE(PG8_SA(1, 1), a1 + hstep, voffA);
            PG8_WAIT_L(8); PG8_BAR; PG8_WAIT_L(0); PG8_MMA(0, 0, At, B0); PG8_BAR; PG8_SCHED;
            PG8_LDB(B1, 0, 1); PG8_STAGE(PG8_SB(0, 0), b2, voffB);
            PG8_BAR; PG8_WAIT_L(0); PG8_MMA(0, 1, At, B1); PG8_BAR;
            PG8_LDA(At, 0, 1); PG8_STAGE(PG8_SA(0, 0), a2, voffA);
            PG8_BAR; PG8_WAIT_L(0); PG8_MMA(1, 0, At, B0); PG8_BAR; PG8_SCHED;
            PG8_STAGE(PG8_SB(0, 1), b2 + hstep, voffB);
            PG8_WAIT_V(6); PG8_BAR; PG8_MMA(1, 1, At, B1); PG8_BAR;
            PG8_LDB(B0, 1, 0); PG8_SCHED; PG8_LDA(At, 1, 0); PG8_STAGE(PG8_SA(0, 1), a2 + hstep, voffA);
            PG8_WAIT_L(8); PG8_BAR; PG8_WAIT_L(0); PG8_MMA(0, 0, At, B0); PG8_BAR; PG8_SCHED;
            PG8_LDB(B1, 1, 1); PG8_STAGE(PG8_SB(1, 0), b3, voffB);
            PG8_BAR; PG8_WAIT_L(0); PG8_MMA(0, 1, At, B1); PG8_BAR;
            PG8_LDA(At, 1, 1); PG8_STAGE(PG8_SA(1, 0), a3, voffA);
            PG8_BAR; PG8_WAIT_L(0); PG8_MMA(1, 0, At, B0); PG8_BAR; PG8_SCHED;
            PG8_STAGE(PG8_SB(1, 1), b3 + hstep, voffB);
            PG8_WAIT_V(6); PG8_BAR; PG8_MMA(1, 1, At, B1); PG8_BAR;
            }
        }
        if constexpr (ALIGN_EPI) { if (wr == 0) PG8_BAR; }
        if constexpr (!Epi::AFTER_DRAIN) { E(acc, cur, wr, wc, fr, fq); S.done(cur); }
        if (!has_next) break;
#pragma unroll
        for (int a = 0; a < 2; ++a)
#pragma unroll
            for (int b = 0; b < 2; ++b)
#pragma unroll
                for (int m = 0; m < 4; ++m)
#pragma unroll
                    for (int n = 0; n < 2; ++n) acc[a][b][m][n] = (f32x4){0.f, 0.f, 0.f, 0.f};
        cur = nxt; cA = nA; cB = nB; ++ui;
        if constexpr (ALIGN_EPI) { if (wr == 1) PG8_BAR; }
    }
    PG8_WAIT_V(0);
    if constexpr (!ALIGN_EPI) { if (wr == 0) PG8_BAR; }
    PG8_BAR;
    if constexpr (Epi::AFTER_DRAIN) { E.fused(acc, cur, wr, wc, fr, fq, lds, wid, lane); S.done(cur); }
#undef PG8_SA
#undef PG8_SB
#undef PG8_STAGE
#undef PG8_LDA
#undef PG8_LDB
#undef PG8_MMA
#undef PG8_WAIT_V
#undef PG8_WAIT_L
#undef PG8_BAR
#undef PG8_SCHED
}
}
namespace attn_body {
using bf16=__hip_bfloat16;
using bf16x8=__attribute__((ext_vector_type(8)))short;
using s16x4=__attribute__((ext_vector_type(4)))short;
using f32x16=__attribute__((ext_vector_type(16)))float;
using u32x4=__attribute__((ext_vector_type(4)))unsigned;
constexpr int D=64,QP=512,KP=128,OP=1024;
constexpr int NW=8,QBLK=32,QB=QBLK*NW,KVBLK=64;
__device__ __forceinline__ int crow(int r,int hi){return (r&3)+8*(r>>2)+4*hi;}
#define SBAR() __builtin_amdgcn_sched_barrier(0)
constexpr int NSLOT=3, SLOTB=8192;
constexpr int LDS_K=0, LDS_V=NSLOT*SLOTB, LDS_WS=2*NSLOT*SLOTB, LDS_OST=LDS_WS+NW*64*4, LDS_BYTES=LDS_OST+NW*4096;
constexpr float C2=0.125f*1.4426950408889634f;
__device__ __forceinline__ void glds16(const void*gsrc,unsigned lds_dst){unsigned keep;
  asm volatile("s_mov_b32 %0, m0\n\ts_mov_b32 m0, %2\n\ts_nop 0\n\tglobal_load_lds_dwordx4 %1, off\n\ts_mov_b32 m0, %0":"=&s"(keep):"v"(gsrc),"s"(lds_dst):"memory");}
__device__ __forceinline__ float max3f(float a,float b,float c){float r;asm("v_max3_f32 %0, %1, %2, %3":"=v"(r):"v"(a),"v"(b),"v"(c));return r;}
__device__ __forceinline__ float max2f(float a,float b){float r;asm("v_max_f32_e32 %0, %1, %2":"=v"(r):"v"(a),"v"(b));return r;}
__device__ __forceinline__ float fadd_s(float a,float b){float r;asm("v_add_f32_e32 %0, %1, %2":"=v"(r):"v"(a),"v"(b));return r;}
__device__ __forceinline__ float fsub_s(float a,float b){float r;asm("v_sub_f32_e32 %0, %1, %2":"=v"(r):"v"(a),"v"(b));return r;}
typedef float f32x2_t __attribute__((ext_vector_type(2))); typedef __bf16 bf16x2_t __attribute__((ext_vector_type(2)));
__device__ __forceinline__ unsigned cvtpk_s(float lo,float hi){f32x2_t v={lo,hi};bf16x2_t b=__builtin_convertvector(v,bf16x2_t);return __builtin_bit_cast(unsigned,b);}
#define WAIT_BAR(N) asm volatile("s_waitcnt vmcnt(" #N ") lgkmcnt(0)\n\ts_barrier":::"memory")

__device__ __forceinline__ void qkt(f32x16&p0,f32x16&p1,const char*Kslot,const bf16x8*qr,const f32x16&negm,int r32,int hi){
  const char*kb=Kslot+hi*1024+r32*16;
  #pragma unroll
  for(int d0=0;d0<4;++d0){
    const bf16x8 b0=*reinterpret_cast<const bf16x8*>(kb+d0*2048);
    const bf16x8 b1=*reinterpret_cast<const bf16x8*>(kb+d0*2048+512);
    if(d0==0){p0=__builtin_amdgcn_mfma_f32_32x32x16_bf16(b0,qr[0],negm,0,0,0);p1=__builtin_amdgcn_mfma_f32_32x32x16_bf16(b1,qr[0],negm,0,0,0);}
    else{p0=__builtin_amdgcn_mfma_f32_32x32x16_bf16(b0,qr[d0],p0,0,0,0);p1=__builtin_amdgcn_mfma_f32_32x32x16_bf16(b1,qr[d0],p1,0,0,0);}}
}
typedef __attribute__((address_space(3))) const char* lds_cptr;
typedef short v4i16_t __attribute__((ext_vector_type(4)));
__device__ __forceinline__ void kload8(bf16x8*kf,lds_cptr kp){
  kf[0]=*(const __attribute__((address_space(3))) bf16x8*)(kp);      kf[1]=*(const __attribute__((address_space(3))) bf16x8*)(kp+512);
  kf[2]=*(const __attribute__((address_space(3))) bf16x8*)(kp+2048); kf[3]=*(const __attribute__((address_space(3))) bf16x8*)(kp+2560);
  kf[4]=*(const __attribute__((address_space(3))) bf16x8*)(kp+4096); kf[5]=*(const __attribute__((address_space(3))) bf16x8*)(kp+4608);
  kf[6]=*(const __attribute__((address_space(3))) bf16x8*)(kp+6144); kf[7]=*(const __attribute__((address_space(3))) bf16x8*)(kp+6656);
}
__device__ __forceinline__ void kload2(bf16x8*kf,lds_cptr kp,int j){ kf[2*j]=*(const __attribute__((address_space(3))) bf16x8*)(kp+j*2048); kf[2*j+1]=*(const __attribute__((address_space(3))) bf16x8*)(kp+j*2048+512); }
__device__ __forceinline__ s16x4 vtr(lds_cptr p){ return __builtin_bit_cast(s16x4,__builtin_amdgcn_ds_read_tr16_b64_v4i16((__attribute__((address_space(3))) v4i16_t*)p)); }
__device__ __forceinline__ float rowmax(const f32x16&p0,const f32x16&p1){
  float a=max3f(p0[0],p0[1],p1[0]),b=max3f(p0[2],p0[3],p1[1]);a=max3f(a,p1[2],p1[3]);
  #pragma unroll
  for(int r=4;r<16;r+=4){a=max3f(a,p0[r],p0[r+1]);b=max3f(b,p0[r+2],p0[r+3]);a=max3f(a,p1[r],p1[r+1]);b=max3f(b,p1[r+2],p1[r+3]);}
  const float m=max2f(a,b);
  auto rr=__builtin_amdgcn_permlane32_swap(__float_as_uint(m),__float_as_uint(m),false,false);
  return max2f(__uint_as_float(rr[0]),__uint_as_float(rr[1]));
}
__device__ __forceinline__ void pv(f32x16*o,int vb,bf16x8 pa0,bf16x8 pa1,bf16x8 pa2,bf16x8 pa3){
  #pragma unroll
  for(int d0=0;d0<2;++d0){s16x4 lo[4],hi[4];
    #pragma unroll
    for(int ks=0;ks<4;++ks){
      asm volatile("ds_read_b64_tr_b16 %0,%1 offset:%c2":"=&v"(lo[ks]):"v"(vb),"i"(d0*4096+ks*1024):"memory");
      asm volatile("ds_read_b64_tr_b16 %0,%1 offset:%c2":"=&v"(hi[ks]):"v"(vb),"i"(d0*4096+ks*1024+512):"memory");}
    asm volatile("s_waitcnt lgkmcnt(0)":::"memory");SBAR();
    #define PK(k) (bf16x8){lo[k][0],lo[k][1],lo[k][2],lo[k][3],hi[k][0],hi[k][1],hi[k][2],hi[k][3]}
    o[d0]=__builtin_amdgcn_mfma_f32_32x32x16_bf16(pa0,PK(0),o[d0],0,0,0);
    o[d0]=__builtin_amdgcn_mfma_f32_32x32x16_bf16(pa1,PK(1),o[d0],0,0,0);
    o[d0]=__builtin_amdgcn_mfma_f32_32x32x16_bf16(pa2,PK(2),o[d0],0,0,0);
    o[d0]=__builtin_amdgcn_mfma_f32_32x32x16_bf16(pa3,PK(3),o[d0],0,0,0);
    #undef PK
  }
}

#ifndef ATTN_STORE16
#define ATTN_STORE16(p,v) (*(u32x4*)(p)=(v))
#endif
template<int THRL,bool SREF> __device__ __forceinline__ void attn_unit(float mref,long rowbase,long orowbase,int S,int h,int kvh,int qb,const bf16*Q,const bf16*__restrict__ K,const bf16*__restrict__ V,bf16*O,char*shm){
  int tid_l=threadIdx.x; asm volatile("":"+v"(tid_l));
  const int tid=tid_l,lane=tid&63,r32=lane&31,hi=lane>>5; const int wid=__builtin_amdgcn_readfirstlane(tid>>6);
  const int q0=qb*QB;
  const bf16*Qw=Q+(rowbase+q0+wid*QBLK)*QP+h*D;
  const bf16*Kh=K+rowbase*KP+kvh*D,*Vh=V+rowbase*KP+kvh*D;
  const unsigned lds0=(unsigned)(uintptr_t)shm;
  float*wsf=(float*)(shm+LDS_WS)+wid*64;
  const bf16*ksrc=Kh+(long)lane*KP+wid*8;
  const bf16*vsrc=Vh+(long)(16*(wid&3)+(lane>>2))*KP+(wid>>2)*32+(lane&3)*8;
  const unsigned kdst=lds0+LDS_K+wid*1024, vdst=lds0+LDS_V+wid*1024;
  #define DMA_K(t,slot) glds16(ksrc+(long)(t)*KVBLK*KP,(unsigned)__builtin_amdgcn_readfirstlane(kdst+(slot)))
  #define DMA_V(t,slot) glds16(vsrc+(long)(t)*KVBLK*KP,(unsigned)__builtin_amdgcn_readfirstlane(vdst+(slot)))
  const int vb0=(int)(lds0+LDS_V)+((lane>>4)&1)*32+(lane&3)*8+(4*hi+((lane&15)>>2))*64;
  const char*Kbase=shm+LDS_K; bf16x8 kf[8];
  const lds_cptr shm3=(lds_cptr)shm; const lds_cptr kp0=shm3+LDS_K+hi*1024+r32*16; const lds_cptr vp0=shm3+LDS_V+((lane>>4)&1)*32+(lane&3)*8+(4*hi+((lane&15)>>2))*64;
  const int NT=S/KVBLK;
  DMA_K(0,0);DMA_V(0,0);DMA_K(1,SLOTB);
  bf16x8 qr[4];
  #pragma unroll
  for(int d0=0;d0<4;++d0)qr[d0]=*reinterpret_cast<const bf16x8*>(&Qw[(long)r32*QP+d0*16+hi*8]);
  float mhat=0.f,l_reg=0.f;f32x16 o[2];o[0]=f32x16{};o[1]=f32x16{};f32x16 negm=f32x16{}; if constexpr(SREF){ _Pragma("unroll") for(int r=0;r<16;++r)negm[r]=-mref; } asm volatile("":"+v"(negm));
  #define CMASK(P0,P1,t) do{}while(0)
  bool resc=false;
  #define START(P0,P1) do{ resc=false; \
    if constexpr(!SREF){ const float rm=rowmax(P0,P1); const float dl=rm; mhat=fadd_s(mhat,dl); \
      _Pragma("unroll") for(int r=0;r<16;++r){P0[r]=fsub_s(P0[r],dl);P1[r]=fsub_s(P1[r],dl);} \
      _Pragma("unroll") for(int r=0;r<16;++r)negm[r]=-mhat; asm volatile("":"+v"(negm)); } \
    _Pragma("unroll") for(int r=0;r<16;++r)P0[r]=__builtin_amdgcn_exp2f(P0[r]); }while(0)
  #define RESC() do{ if constexpr(!SREF) if(resc){ asm volatile("s_waitcnt lgkmcnt(0)":::"memory"); \
      _Pragma("unroll") for(int d_=0;d_<2;++d_) _Pragma("unroll") for(int r=0;r<16;++r)o[d_][r]*=wsf[crow(r,hi)]; } }while(0)
  f32x16 pA0,pA1,pB0,pB1;
  int sl_prev=0,sl_cur=0,sl_next=SLOTB;
  #define ROT() do{sl_prev=sl_cur;sl_cur=sl_next;sl_next=(sl_next==(NSLOT-1)*SLOTB)?0:sl_next+SLOTB;}while(0)
  DMA_K(2,2*SLOTB);
  WAIT_BAR(3);
  qkt(pA0,pA1,Kbase,qr,negm,r32,hi);asm volatile("s_nop 15\n\ts_nop 7":"+v"(pA0),"+v"(pA1));CMASK(pA0,pA1,0);
  START(pA0,pA1);
  _Pragma("unroll") for(int r=0;r<16;++r)pA1[r]=__builtin_amdgcn_exp2f(pA1[r]);
  WAIT_BAR(0);
  DMA_K(3,0);DMA_V(1,SLOTB);
  ROT();
  kload8(kf,kp0+sl_cur);
  WAIT_BAR(2);
  s16x4 vlo[8],vhi[8]; u32x4 pw0,pw1,pw2,pw3;
  #define PKW(P,B) cvtpk_s(P[B],P[B+1])
  #define PAF(k) __builtin_bit_cast(bf16x8,pw##k)
  #define VFR(i) (bf16x8){vlo[i][0],vlo[i][1],vlo[i][2],vlo[i][3],vhi[i][0],vhi[i][1],vhi[i][2],vhi[i][3]}
  #define PIN(x) asm volatile("":"+v"(x))
  #define MX3(a,b,c) __builtin_fmaxf(__builtin_fmaxf((a),(b)),(c))
  #define GAPA(MF,A0,A1,A2,A3,W0,W1,PW) do{ MF; sacc+=A0; sacc+=A1; sacc+=A2; sacc+=A3; PIN(sacc); W0; W1; PIN(PW); SBAR(); }while(0)
  #define EX(v) __builtin_amdgcn_exp2f(v)
  #define GAPB(MF,X,B) do{ MF; X[B]=EX(X[B]); X[B+1]=EX(X[B+1]); X[B+2]=EX(X[B+2]); X[B+3]=EX(X[B+3]); PIN(X); SBAR(); }while(0)
  #define VRD(i) do{ vlo[i]=vtr(vp_+(((i)>>2)*4096+((i)&3)*1024)); vhi[i]=vtr(vp_+(((i)>>2)*4096+((i)&3)*1024+512)); }while(0)
  #define KRD(G,j) do{ if(G){ kload2(kf,kp0+sl_next,j); SBAR(); } }while(0)
  #define STEP(C0,C1,P0,P1,t,GK,GV,GL) do{ SBAR(); \
    const lds_cptr vp_=vp0+sl_prev; \
    VRD(0); SBAR(); float sacc=(P0[0]+P0[1]); \
    GAPA(C0=__builtin_amdgcn_mfma_f32_32x32x16_bf16(kf[0],qr[0],negm,0,0,0), P0[2],P0[3],P0[4],P0[5],     pw0[0]=PKW(P0,0), pw0[1]=PKW(P0,2), pw0); \
    VRD(4); SBAR(); GAPA(C1=__builtin_amdgcn_mfma_f32_32x32x16_bf16(kf[1],qr[0],negm,0,0,0), P0[6],P0[7],P0[8],P0[9],     pw0[2]=PKW(P0,4), pw0[3]=PKW(P0,6), pw0); \
    VRD(1); SBAR(); GAPA(C0=__builtin_amdgcn_mfma_f32_32x32x16_bf16(kf[2],qr[1],C0,0,0,0),   P0[10],P0[11],P0[12],P0[13], pw1[0]=PKW(P0,8), pw1[1]=PKW(P0,10), pw1); \
    VRD(5); SBAR(); GAPA(C1=__builtin_amdgcn_mfma_f32_32x32x16_bf16(kf[3],qr[1],C1,0,0,0),   P0[14],P0[15],P1[0],P1[1],   pw1[2]=PKW(P0,12),pw1[3]=PKW(P0,14), pw1); \
    VRD(2); SBAR(); GAPA(C0=__builtin_amdgcn_mfma_f32_32x32x16_bf16(kf[4],qr[2],C0,0,0,0),   P1[2],P1[3],P1[4],P1[5],     pw2[0]=PKW(P1,0), pw2[1]=PKW(P1,2), pw2); \
    VRD(6); SBAR(); GAPA(C1=__builtin_amdgcn_mfma_f32_32x32x16_bf16(kf[5],qr[2],C1,0,0,0),   P1[6],P1[7],P1[8],P1[9],     pw2[2]=PKW(P1,4), pw2[3]=PKW(P1,6), pw2); \
    VRD(3); SBAR(); GAPA(C0=__builtin_amdgcn_mfma_f32_32x32x16_bf16(kf[6],qr[3],C0,0,0,0),   P1[10],P1[11],P1[12],P1[13], pw3[0]=PKW(P1,8), pw3[1]=PKW(P1,10), pw3); \
    VRD(7); SBAR(); GAPA(C1=__builtin_amdgcn_mfma_f32_32x32x16_bf16(kf[7],qr[3],C1,0,0,0),   P1[14],P1[15],0.f,0.f,       pw3[2]=PKW(P1,12),pw3[3]=PKW(P1,14), pw3); \
    l_reg+=sacc; \
    if(GK){DMA_K((t)+3,sl_cur);} if(GV){DMA_V((t)+1,sl_next);} \
    CMASK(C0,C1,t); \
    if constexpr(!SREF){ float a=MX3(C0[0],C0[1],C1[0]),b=MX3(C0[2],C0[3],C1[1]); a=MX3(a,C1[2],C1[3]); \
      _Pragma("unroll") for(int r=4;r<16;r+=4){a=MX3(a,C0[r],C0[r+1]);b=MX3(b,C0[r+2],C0[r+3]);a=MX3(a,C1[r],C1[r+1]);b=MX3(b,C1[r+2],C1[r+3]);} \
      float rm=__builtin_fmaxf(a,b); { auto rr=__builtin_amdgcn_permlane32_swap(__float_as_uint(rm),__float_as_uint(rm),false,false); rm=__builtin_fmaxf(__uint_as_float(rr[0]),__uint_as_float(rr[1])); } \
      resc=false; \
      if(__builtin_expect(__any(rm>(float)THRL),0)){ const float dl=__builtin_fmaxf(rm,0.f); mhat+=dl; \
        _Pragma("unroll") for(int r=0;r<16;++r){C0[r]-=dl;C1[r]-=dl;} \
        _Pragma("unroll") for(int r=0;r<16;++r)negm[r]=-mhat; asm volatile("":"+v"(negm)); \
        const float f=__builtin_amdgcn_exp2f(-dl); l_reg*=f; if(hi==0)wsf[r32]=f; resc=true; } } \
    SBAR(); \
    GAPB(o[0]=__builtin_amdgcn_mfma_f32_32x32x16_bf16(PAF(0),VFR(0),o[0],0,0,0), C0,0); \
    GAPB(o[1]=__builtin_amdgcn_mfma_f32_32x32x16_bf16(PAF(0),VFR(4),o[1],0,0,0), C0,4); \
    KRD(GL,0); GAPB(o[0]=__builtin_amdgcn_mfma_f32_32x32x16_bf16(PAF(1),VFR(1),o[0],0,0,0), C0,8); \
    KRD(GL,1); GAPB(o[1]=__builtin_amdgcn_mfma_f32_32x32x16_bf16(PAF(1),VFR(5),o[1],0,0,0), C0,12); \
    KRD(GL,2); GAPB(o[0]=__builtin_amdgcn_mfma_f32_32x32x16_bf16(PAF(2),VFR(2),o[0],0,0,0), C1,0); \
    KRD(GL,3); GAPB(o[1]=__builtin_amdgcn_mfma_f32_32x32x16_bf16(PAF(2),VFR(6),o[1],0,0,0), C1,4); \
    GAPB(o[0]=__builtin_amdgcn_mfma_f32_32x32x16_bf16(PAF(3),VFR(3),o[0],0,0,0), C1,8); \
    GAPB(o[1]=__builtin_amdgcn_mfma_f32_32x32x16_bf16(PAF(3),VFR(7),o[1],0,0,0), C1,12); \
    }while(0)
  int t=1;
  #undef CMASK
  #define CMASK(P0,P1,t) do{}while(0)
  for(;t+5<NT;t+=2){
    STEP(pB0,pB1,pA0,pA1,t,true,true,true);     WAIT_BAR(2); RESC(); ROT();
    STEP(pA0,pA1,pB0,pB1,t+1,true,true,true);   WAIT_BAR(2); RESC(); ROT();
  }
  #undef CMASK
  #define CMASK(P0,P1,t) do{}while(0)
  #define ENDW(tt) do{ if((tt)+3<NT){WAIT_BAR(2);} else if((tt)+2<NT){WAIT_BAR(1);} else {WAIT_BAR(0);} }while(0)
  for(;t+1<NT;t+=2){
    STEP(pB0,pB1,pA0,pA1,t,(t+3<NT),(t+1<NT),(t+1<NT));       ENDW(t);   RESC(); ROT();
    STEP(pA0,pA1,pB0,pB1,t+1,(t+4<NT),(t+2<NT),(t+2<NT));     ENDW(t+1); RESC(); ROT();
  }
  STEP(pB0,pB1,pA0,pA1,NT-1,false,false,false); RESC();
  { float sacc=pB0[0]+pB0[1]; _Pragma("unroll") for(int r=2;r<16;++r)sacc+=pB0[r]; _Pragma("unroll") for(int r=0;r<16;++r)sacc+=pB1[r]; l_reg+=sacc;
    pw0=(u32x4){PKW(pB0,0),PKW(pB0,2),PKW(pB0,4),PKW(pB0,6)};pw1=(u32x4){PKW(pB0,8),PKW(pB0,10),PKW(pB0,12),PKW(pB0,14)};pw2=(u32x4){PKW(pB1,0),PKW(pB1,2),PKW(pB1,4),PKW(pB1,6)};pw3=(u32x4){PKW(pB1,8),PKW(pB1,10),PKW(pB1,12),PKW(pB1,14)};
    SBAR(); pv(o,vb0+sl_cur,PAF(0),PAF(1),PAF(2),PAF(3)); }
  #undef PKW
  #undef PAF
  #undef VFR
  #undef PIN
  #undef MX3
  #undef GAPA
  #undef GAPB
  #undef EX
  #undef VRD
  #undef KRD
  #undef STEP
  #undef ENDW
  {auto rr=__builtin_amdgcn_permlane32_swap(__float_as_uint(l_reg),__float_as_uint(l_reg),false,false);l_reg=__uint_as_float(rr[0])+__uint_as_float(rr[1]);}
  if(hi==0)wsf[32+r32]=l_reg;asm volatile("s_waitcnt lgkmcnt(0)":::"memory");
  float rli[16];
  #pragma unroll
  for(int r=0;r<16;++r)rli[r]=__builtin_amdgcn_rcpf(wsf[32+crow(r,hi)]);
  bf16*Ow=O+(orowbase+q0+wid*QBLK)*OP+h*D;
  { bf16*stg=(bf16*)(shm+LDS_OST)+wid*2048;
    #pragma unroll
    for(int r=0;r<16;++r){const int orow=crow(r,hi);
      #pragma unroll
      for(int d0=0;d0<2;++d0)stg[orow*64+d0*32+r32]=__float2bfloat16(o[d0][r]*rli[r]);}
    asm volatile("s_waitcnt lgkmcnt(0)":::"memory");
    #pragma unroll
    for(int i=0;i<4;++i){const int row=i*8+(lane>>3),ch=lane&7; const u32x4 v=*(const u32x4*)(stg+row*64+ch*8); ATTN_STORE16(Ow+(long)row*OP+ch*8,v);} }
  asm volatile("s_waitcnt lgkmcnt(0)\n\ts_barrier":::"memory");
  #undef DMA_K
  #undef DMA_V
  #undef CMASK
  #undef START
  #undef RESC
  #undef ROT
}
constexpr int ATTN_LDS_BYTES=LDS_BYTES;
#undef SBAR
#undef WAIT_BAR
}
constexpr int DMODEL = 1024, NTOK = 131072, NTP = 65536, DFF = 2816, NPROJ = 2304, NBATCH = 24, NLAYER = 2, NMOD = 6144;
constexpr int NWAVES = 8, NTHREADS = 512;
constexpr int LDS_TOTAL = 147456;
constexpr float RMS_EPS = 1e-6f;
constexpr size_t MiB = 1u << 20;
constexpr size_t WS_BAR = 1u << 20, WS_BAR_BYTES = 65536;
constexpr size_t WS_ROT = 0;
constexpr size_t WS_MOD = 2 * MiB;
constexpr size_t WS_W = 4 * MiB;
constexpr size_t W_IN = 0, W_OUT = W_IN + (size_t)NPROJ * 1024 * 2, W_GU = W_OUT + (size_t)1024 * 1024 * 2, W_DN = W_GU + (size_t)2 * DFF * 1024 * 2, W_LAYER = W_DN + (size_t)1024 * DFF * 2;
static_assert(WS_W + 2 * W_LAYER <= 52 * MiB, "weights");
constexpr size_t WS_H = 52 * MiB;
constexpr size_t WS_F = 308 * MiB;
constexpr size_t WS_Q = WS_F, WS_K = WS_Q + 128 * MiB, WS_V = WS_K + 32 * MiB, WS_BG = WS_V + 32 * MiB, WS_CU = WS_BG + 128 * MiB, WS_MODP = WS_CU + 128 * MiB;
constexpr int MOD_KC = 32;
constexpr size_t WS_END = WS_F + (size_t)NTOK * DFF * 2;
static_assert(WS_ROT == pg8::PWS_ROT && WS_F == pg8::PWS_F && 8 * pg8::TEAM_SLICE == (size_t)NTOK * DFF * 2, "EpiProj / EpiSwiglu offsets");
static_assert(WS_MODP + (size_t)MOD_KC * NLAYER * NBATCH * NMOD * 4 <= WS_END && WS_END <= 1024 * MiB, "d_ws map");

#define LAS __attribute__((address_space(3)))
typedef unsigned short bf16;
typedef unsigned v4u __attribute__((ext_vector_type(4)));
typedef unsigned v2u __attribute__((ext_vector_type(2)));
typedef float f32x4 __attribute__((ext_vector_type(4)));
__device__ __forceinline__ unsigned pk2(float lo, float hi) { return pg8::cvt_pk_bf16(lo, hi); }
__device__ __forceinline__ float wave_sum(float v) {
#pragma unroll
    for (int o = 1; o < 64; o <<= 1) v += __shfl_xor(v, o);
    return v;
}
__device__ __forceinline__ int batch_of_row(int row) { return row < NTP ? (row >> 13) : 8 + ((row - NTP) >> 12); }
__device__ __forceinline__ int team_tile(int m, int x) { return m < 32 ? 32 * x + m : 256 + 32 * x + (m - 32); }

struct Args {
    const float *xp, *xs, *cp, *cs, *w_mod, *b_mod, *g_mix, *w_in, *q_gain, *k_gain, *conv_w, *w_out, *g_ffn, *w_gate, *w_up, *w_down, *g_final;
    float* out; unsigned char* ws; int G; int pad;
};

__device__ __forceinline__ void transpose_item(const float* W, int K, int N, bf16* WT, int k0, int n0, int dst_row0, LAS float* scr, int lane) {
    float wv[32];
#pragma unroll
    for (int i = 0; i < 32; ++i) wv[i] = __builtin_nontemporal_load(W + (size_t)(k0 + 2 * i + (lane >> 5)) * N + n0 + (lane & 31));
#pragma unroll
    for (int i = 0; i < 32; ++i) scr[(2 * i + (lane >> 5)) * 33 + (lane & 31)] = wv[i];
    asm volatile("s_waitcnt lgkmcnt(0)" ::: "memory");
    const int c = lane & 7;
#pragma unroll
    for (int j = 0; j < 4; ++j) { const int n = (lane >> 3) + 8 * j; const LAS float* s = scr + (8 * c) * 33 + n;
        v4u o; o.x = pk2(s[0 * 33], s[1 * 33]); o.y = pk2(s[2 * 33], s[3 * 33]); o.z = pk2(s[4 * 33], s[5 * 33]); o.w = pk2(s[6 * 33], s[7 * 33]);
        *(v4u*)(WT + (size_t)(dst_row0 + n) * K + k0 + 8 * c) = o; }
    asm volatile("s_waitcnt lgkmcnt(0)" ::: "memory");
}
__device__ __forceinline__ int proj_row(int L) {
    if (L < 1280) { const int grp = L >> 6, d = L & 63; return 256 * (grp >> 2) + 128 * (d >> 5) + 32 * (grp & 3) + (d & 31); }
    if (L < 1792) { const int ch = L - 1280; return 256 * (5 + (ch >> 7)) + (ch & 127); }
    const int ch = L - 1792; return 256 * (5 + (ch >> 7)) + 128 + (ch & 127);
}

__device__ __forceinline__ void phase_prologue(const __attribute__((address_space(4))) Args& a, LAS unsigned char* lds, int gw, int NGW, int wave, int lane) {
    unsigned char* ws = a.ws;
    {
        LAS float* scr = (LAS float*)(lds + wave * 16384);
        constexpr int I_IN = 16 * (NPROJ / 32), I_OUT = 16 * 32, I_G = 16 * (DFF / 32), I_D = (DFF / 64) * 32, I_LAYER = I_IN + I_OUT + 2 * I_G + I_D;
        for (int it = gw; it < NLAYER * I_LAYER; it += NGW) {
            const int l = it / I_LAYER; int r = it % I_LAYER; unsigned char* wl = ws + WS_W + l * W_LAYER;
            if (r < I_IN) { const int nb = NPROJ / 32, k0 = 64 * (r / nb), n0 = 32 * (r % nb); transpose_item(a.w_in + (size_t)l * 1024 * NPROJ, 1024, NPROJ, (bf16*)(wl + W_IN), k0, n0, proj_row(n0), scr, lane); continue; } r -= I_IN;
            if (r < I_OUT) { const int k0 = 64 * (r / 32), n0 = 32 * (r % 32); transpose_item(a.w_out + (size_t)l * 1024 * 1024, 1024, 1024, (bf16*)(wl + W_OUT), k0, n0, n0, scr, lane); continue; } r -= I_OUT;
            if (r < I_G) { const int nb = DFF / 32, k0 = 64 * (r / nb), n0 = 32 * (r % nb); transpose_item(a.w_gate + (size_t)l * 1024 * DFF, 1024, DFF, (bf16*)(wl + W_GU), k0, n0, 256 * (n0 >> 7) + (n0 & 127), scr, lane); continue; } r -= I_G;
            if (r < I_G) { const int nb = DFF / 32, k0 = 64 * (r / nb), n0 = 32 * (r % nb); transpose_item(a.w_up + (size_t)l * 1024 * DFF, 1024, DFF, (bf16*)(wl + W_GU), k0, n0, 256 * (n0 >> 7) + 128 + (n0 & 127), scr, lane); continue; } r -= I_G;
            { const int k0 = 64 * (r / 32), n0 = 32 * (r % 32); transpose_item(a.w_down + (size_t)l * DFF * 1024, DFF, 1024, (bf16*)(wl + W_DN), k0, n0, n0, scr, lane); }
        }
    }
    if (blockIdx.x == 0) {
        float* rot = (float*)(ws + WS_ROT);
        for (int i = threadIdx.x; i < 128 * 16; i += NTHREADS) { const int pos = i >> 4, j = i & 15; const float inv = powf(10000.0f, -(float)j / 16.0f); const float ang = (float)pos * inv;
            rot[2 * i] = cosf(ang); rot[2 * i + 1] = sinf(ang); }
    }
    __syncthreads();
    {
        LAS float* sc = (LAS float*)lds;
        for (int i = threadIdx.x; i < NBATCH * 1024; i += NTHREADS) { const float v = i < 8 * 1024 ? a.cp[i] : a.cs[i - 8 * 1024]; sc[i] = v / (1.0f + __expf(-v)); }
        __syncthreads();
        float* modp = (float*)(ws + WS_MODP);
        constexpr int NCG = NMOD / 64, ITEMS = NLAYER * NCG * MOD_KC;
        for (int it = gw; it < ITEMS; it += NGW) {
            const int kc = it % MOD_KC, cgp = (it / MOD_KC) % NCG, l = it / (MOD_KC * NCG);
            const float* wp = a.w_mod + (size_t)l * 1024 * NMOD + (size_t)(kc * 32) * NMOD + cgp * 64 + lane;
            float accb[NBATCH];
#pragma unroll
            for (int b = 0; b < NBATCH; ++b) accb[b] = 0.f;
            float wall[32];
#pragma unroll
            for (int j = 0; j < 32; ++j) wall[j] = __builtin_nontemporal_load(wp + (size_t)j * NMOD);
#pragma unroll
            for (int k4 = 0; k4 < 8; ++k4) {
                float w[4];
#pragma unroll
                for (int j = 0; j < 4; ++j) w[j] = wall[k4 * 4 + j];
#pragma unroll
                for (int b = 0; b < NBATCH; ++b) { const f32x4 s = *(const LAS f32x4*)(sc + b * 1024 + kc * 32 + k4 * 4); accb[b] += (w[0] * s[0] + w[1] * s[1]) + (w[2] * s[2] + w[3] * s[3]); }
            }
            float* o = modp + ((size_t)(kc * NLAYER + l) * NBATCH) * NMOD + cgp * 64 + lane;
#pragma unroll
            for (int b = 0; b < NBATCH; ++b) o[(size_t)b * NMOD] = accb[b];
        }
    }
}
__device__ __forceinline__ void phase_mod_final(const __attribute__((address_space(4))) Args& a) {
    const float* modp = (const float*)(a.ws + WS_MODP); float* mod = (float*)(a.ws + WS_MOD);
    for (int i = blockIdx.x * NTHREADS + threadIdx.x; i < NLAYER * NBATCH * NMOD; i += gridDim.x * NTHREADS) {
        const int n = i % NMOD, l = i / (NBATCH * NMOD); float s = a.b_mod[l * NMOD + n];
#pragma unroll 8
        for (int kc = 0; kc < MOD_KC; ++kc) s += modp[(size_t)kc * NLAYER * NBATCH * NMOD + i];
        mod[i] = s;
    }
}
__device__ __forceinline__ void wave_sum4(float (&s)[4]) {
#pragma unroll
    for (int o = 1; o < 64; o <<= 1) {
#pragma unroll
        for (int i = 0; i < 4; ++i) s[i] += __shfl_xor(s[i], o); }
}
__device__ __forceinline__ void unpack8v(const v4u p, f32x4& a, f32x4& b) {
    a = (f32x4){__uint_as_float(p.x << 16), __uint_as_float(p.x & 0xffff0000u), __uint_as_float(p.y << 16), __uint_as_float(p.y & 0xffff0000u)};
    b = (f32x4){__uint_as_float(p.z << 16), __uint_as_float(p.z & 0xffff0000u), __uint_as_float(p.w << 16), __uint_as_float(p.w & 0xffff0000u)};
}
template <bool IN_BF16>
__device__ __forceinline__ void phase_norm(const float* xa, const float* xb, const bf16* res, const float* g, const float* shift, const float* scale, bf16* H, int x, int wv, int nwv, int lane, int rev) {
    for (int ch0 = wv; ch0 < 1024; ch0 += nwv) {
        const int ch = rev ? 1023 - ch0 : ch0; const int r0 = team_tile(ch >> 4, x) * 256 + (ch & 15) * 16; const int b = batch_of_row(r0); const float* xin = r0 < NTP ? xa : xb;
        f32x4 gs[4], sh[4];
#pragma unroll
        for (int j = 0; j < 4; ++j) { const int c = 8 * lane + 512 * (j >> 1) + 4 * (j & 1); gs[j] = *(const f32x4*)(g + c) * (1.0f + *(const f32x4*)(scale + (size_t)b * NMOD + c)); sh[j] = *(const f32x4*)(shift + (size_t)b * NMOD + c); }
#pragma unroll 1
        for (int r = r0; r < r0 + 16; r += 4) {
            f32x4 v[4][4]; float s[4];
            if constexpr (IN_BF16) {
                v4u p[4][2];
#pragma unroll
                for (int i = 0; i < 4; ++i) { const v4u* xr = (const v4u*)(res + (size_t)(r + i) * 2048) + lane; p[i][0] = xr[0]; p[i][1] = xr[64]; }
#pragma unroll
                for (int i = 0; i < 4; ++i) { unpack8v(p[i][0], v[i][0], v[i][1]); unpack8v(p[i][1], v[i][2], v[i][3]); }
            } else {
#pragma unroll
                for (int i = 0; i < 4; ++i) { const f32x4* xr = (const f32x4*)(xin + (size_t)(r + i) * 1024) + 2 * lane;
                    v[i][0] = __builtin_nontemporal_load(xr); v[i][1] = __builtin_nontemporal_load(xr + 1); v[i][2] = __builtin_nontemporal_load(xr + 128); v[i][3] = __builtin_nontemporal_load(xr + 129); }
            }
#pragma unroll
            for (int i = 0; i < 4; ++i) { s[i] = 0.f;
#pragma unroll
                for (int j = 0; j < 4; ++j) s[i] += (v[i][j][0] * v[i][j][0] + v[i][j][1] * v[i][j][1]) + (v[i][j][2] * v[i][j][2] + v[i][j][3] * v[i][j][3]); }
            wave_sum4(s);
#pragma unroll
            for (int i = 0; i < 4; ++i) { const float rstd = 1.0f / sqrtf(s[i] * (1.0f / 1024.0f) + RMS_EPS);
                v4u* o = (v4u*)(H + (size_t)(r + i) * 1024) + lane;
#pragma unroll
                for (int h = 0; h < 2; ++h) { const f32x4 y0 = v[i][2 * h] * rstd * gs[2 * h] + sh[2 * h], y1 = v[i][2 * h + 1] * rstd * gs[2 * h + 1] + sh[2 * h + 1];
                    v4u w; w.x = pk2(y0[0], y0[1]); w.y = pk2(y0[2], y0[3]); w.z = pk2(y1[0], y1[1]); w.w = pk2(y1[2], y1[3]); o[64 * h] = w; } }
        }
    }
}
__device__ __forceinline__ void phase_final_norm(float* x, const float* g, int tx, int wv, int nwv, int lane) {
    f32x4 gs[4];
#pragma unroll
    for (int j = 0; j < 4; ++j) gs[j] = *(const f32x4*)(g + 8 * lane + 512 * (j >> 1) + 4 * (j & 1));
    for (int st = wv; st < 4096; st += nwv) {
        const int r = team_tile(st >> 6, tx) * 256 + (st & 63) * 4;
        f32x4 v[4][4]; float s[4]; v4u p[4][2];
#pragma unroll
        for (int i = 0; i < 4; ++i) { const v4u* xr = (const v4u*)(x + (size_t)(r + i) * 1024) + lane; p[i][0] = xr[0]; p[i][1] = xr[64]; }
#pragma unroll
        for (int i = 0; i < 4; ++i) { unpack8v(p[i][0], v[i][0], v[i][1]); unpack8v(p[i][1], v[i][2], v[i][3]); }
#pragma unroll
        for (int i = 0; i < 4; ++i) { s[i] = 0.f;
#pragma unroll
            for (int j = 0; j < 4; ++j) s[i] += (v[i][j][0] * v[i][j][0] + v[i][j][1] * v[i][j][1]) + (v[i][j][2] * v[i][j][2] + v[i][j][3] * v[i][j][3]); }
        wave_sum4(s);
#pragma unroll
        for (int i = 0; i < 4; ++i) { const float rstd = 1.0f / sqrtf(s[i] * (1.0f / 1024.0f) + RMS_EPS);
            f32x4* xr = (f32x4*)(x + (size_t)(r + i) * 1024) + 2 * lane;
            __builtin_nontemporal_store(v[i][0] * rstd * gs[0], xr); __builtin_nontemporal_store(v[i][1] * rstd * gs[1], xr + 1);
            __builtin_nontemporal_store(v[i][2] * rstd * gs[2], xr + 128); __builtin_nontemporal_store(v[i][3] * rstd * gs[3], xr + 129); }
    }
}
__device__ __forceinline__ void unpack8(const v4u p, float (&f)[8]) {
#pragma unroll
    for (int i = 0; i < 4; ++i) { f[2 * i] = __uint_as_float(p[i] << 16); f[2 * i + 1] = __uint_as_float(p[i] & 0xffff0000u); }
}
__device__ __forceinline__ void phase_conv(const bf16* Bg, const bf16* CU, const float* cw, bf16* MIX, int x, int wv, int nwv, int lane, int rev) {
    float w0[8], w1[8], w2[8];
#pragma unroll
    for (int i = 0; i < 8; ++i) { w0[i] = cw[8 * lane + i]; w1[i] = cw[512 + 8 * lane + i]; w2[i] = cw[1024 + 8 * lane + i]; }
    const v4u zero = {0u, 0u, 0u, 0u};
    for (int ch0 = wv; ch0 < 2048; ch0 += nwv) {
        const int ch = rev ? 2047 - ch0 : ch0; const int r0 = team_tile(ch >> 5, x) * 256 + (ch & 31) * 8; const int S = r0 < NTP ? 8192 : 4096;
        const v4u* cup = (const v4u*)(CU + (size_t)ch * 8 * 512) + lane;
        const v4u* bgp = (const v4u*)(Bg + (size_t)ch * 8 * 512) + lane;
        v4u cu[10], bg[8];
        cu[0] = ((r0 & (S - 1)) == 0) ? zero : cup[-64];
#pragma unroll
        for (int i = 0; i < 8; ++i) cu[i + 1] = cup[i * 64];
        cu[9] = (((r0 + 8) & (S - 1)) == 0) ? zero : cup[8 * 64];
#pragma unroll
        for (int i = 0; i < 8; ++i) bg[i] = bgp[i * 64];
#pragma unroll
        for (int i = 0; i < 8; ++i) {
            float p[8], c[8], n[8], g[8], o[8]; unpack8(cu[i], p); unpack8(cu[i + 1], c); unpack8(cu[i + 2], n); unpack8(bg[i], g);
#pragma unroll
            for (int k = 0; k < 8; ++k) o[k] = g[k] * (w0[k] * p[k] + w1[k] * c[k] + w2[k] * n[k]);
            v4u w; w.x = pk2(o[0], o[1]); w.y = pk2(o[2], o[3]); w.z = pk2(o[4], o[5]); w.w = pk2(o[6], o[7]);
            *((v4u*)(MIX + (size_t)(r0 + i) * 1024 + 512) + lane) = w;
        }
    }
}
template <bool SREF>
__device__ __forceinline__ void attn_units(float mref, const bf16* Q, const bf16* K, const bf16* V, bf16* MIX, char* lds, int x, int r, int n, int rev) {
    for (int u0 = r; u0 < 512; u0 += n) { const int u = rev ? 511 - u0 : u0;
        long rowbase, orow; int S, h, qb;
        if (u < 256) { rowbase = 0; orow = (long)x * 8192; S = 8192; h = u >> 5; qb = u & 31; }
        else { const int u2 = u - 256, w = u2 & 127; rowbase = 8192 + (long)(u2 >> 7) * 4096; orow = NTP + (long)(2 * x + (u2 >> 7)) * 4096; S = 4096; h = w >> 4; qb = w & 15; }
        attn_body::attn_unit<8, SREF>(mref, rowbase, orow, S, h, h >> 2, qb, (const attn_body::bf16*)Q, (const attn_body::bf16*)K, (const attn_body::bf16*)V, (attn_body::bf16*)MIX, lds);
    }
}
__device__ __forceinline__ void phase_attn(const float* qg, const float* kg, const bf16* Q, const bf16* K, const bf16* V, bf16* MIX, char* lds, int x, int r, int n, int lane, int rev) {
    float qm = fabsf(qg[lane]), km = fabsf(kg[lane]);
#pragma unroll
    for (int o = 1; o < 64; o <<= 1) { qm = fmaxf(qm, __shfl_xor(qm, o)); km = fmaxf(km, __shfl_xor(km, o)); }
    const float mref = __builtin_bit_cast(float, __builtin_amdgcn_readfirstlane(__builtin_bit_cast(int, 8.0f * 1.4426950408889634f * 1.02f * qm * km + 0.25f)));
    if (mref <= 40.0f) attn_units<true>(mref, Q, K, V, MIX, lds, x, r, n, rev);
    else attn_units<false>(0.f, Q, K, V, MIX, lds, x, r, n, rev);
}

#define XB_TMO      128
#define XB_XCNT(j)  (256  + 64 * (j))
#define XB_XSUB(j)  (1280 + 64 * (j))
#define XB_XGEN(j)  (2304 + 64 * (j))
#define XB_TOP      3328
#define XB_TOPGEN   3392
#define XCD_BAR_WORDS 3456
#define XB_SPIN_CAP (1u << 18)

__device__ __forceinline__ unsigned xb_ld(unsigned* p)              { return __hip_atomic_load(p, __ATOMIC_RELAXED, __HIP_MEMORY_SCOPE_AGENT); }
__device__ __forceinline__ unsigned xb_add(unsigned* p, unsigned v) { return __hip_atomic_fetch_add(p, v, __ATOMIC_RELAXED, __HIP_MEMORY_SCOPE_AGENT); }
__device__ __forceinline__ unsigned xb_xcc_id() { return (unsigned)__builtin_amdgcn_s_getreg((3 << 11) | 20) & 0xFu; }
#define XB_SPIN(cond, bar) do { unsigned _sp = 0; while (cond) { __builtin_amdgcn_s_sleep(1); \
    if ((++_sp & 255u) == 0u) { if (xb_ld(&(bar)[XB_TMO])) break; if (_sp > XB_SPIN_CAP) { atomicAdd(&(bar)[XB_TMO], 1u); break; } } } } while (0)

struct XcdBarrier {
    unsigned* bar; unsigned x;
    volatile LAS unsigned* st;
};

__device__ __forceinline__ XcdBarrier xcd_barrier_post(unsigned* bar, volatile LAS unsigned* st) {
    XcdBarrier b; b.bar = bar; b.x = xb_xcc_id(); b.st = st;
    if (threadIdx.x == 0) (void)xb_add(&bar[XB_XCNT(b.x)], 1u);
    return b;
}
__device__ __forceinline__ void xcd_barrier_complete(unsigned* bar, unsigned x, unsigned& nloc, unsigned& nx) {
    const unsigned G = gridDim.x * gridDim.y * gridDim.z;
    unsigned sum, cnt, mine, sp = 0u;
    for (;;) {
        sum = 0u; cnt = 0u; mine = 0u;
#pragma unroll
        for (unsigned j = 0; j < 16; ++j) { const unsigned c = xb_ld(&bar[XB_XCNT(j)]); sum += c; cnt += (c > 0u) ? 1u : 0u; mine = (j == x) ? c : mine; }
        if (sum == G) break;
        __builtin_amdgcn_s_sleep(1);
        if ((++sp & 255u) == 0u) { if (xb_ld(&bar[XB_TMO])) break; if (sp > XB_SPIN_CAP) { atomicAdd(&bar[XB_TMO], 1u); break; } }
    }
    nloc = mine > 0u ? mine : 1u; nx = cnt > 0u ? cnt : 1u;
}

__device__ __forceinline__ void xcd_barrier(const XcdBarrier& b) {
    asm volatile("s_waitcnt vmcnt(0)" ::: "memory");
    __syncthreads();
    if (threadIdx.x == 0) {
        unsigned* bar = b.bar;
        __builtin_amdgcn_s_waitcnt(0);
        unsigned nloc = b.st[0], nx = b.st[1];
        if (nloc == 0u) { xcd_barrier_complete(bar, b.x, nloc, nx); b.st[0] = nloc; b.st[1] = nx; }
        const unsigned old = xb_add(&bar[XB_XSUB(b.x)], 1u);
        const unsigned gen = old / nloc;
        if (old + 1u == (gen + 1u) * nloc) {
            __builtin_amdgcn_fence(__ATOMIC_RELEASE, "agent");
            asm volatile("s_waitcnt vmcnt(0)" ::: "memory");
            const unsigned og = xb_add(&bar[XB_TOP], 1u);
            const unsigned tg = og / nx;
            if (og + 1u == (tg + 1u) * nx) xb_add(&bar[XB_TOPGEN], 1u);
            else XB_SPIN(xb_ld(&bar[XB_TOPGEN]) == tg, bar);
            __builtin_amdgcn_fence(__ATOMIC_ACQUIRE, "agent");
            xb_add(&bar[XB_XGEN(b.x)], 1u);
            asm volatile("s_waitcnt vmcnt(0)" ::: "memory");
        } else {
            XB_SPIN(xb_ld(&bar[XB_XGEN(b.x)]) == gen, bar);
            __builtin_amdgcn_fence(__ATOMIC_ACQUIRE, "agent");
            asm volatile("s_waitcnt vmcnt(0)" ::: "memory");
        }
    }
    __syncthreads();
}


typedef __attribute__((address_space(4))) const Args* KArgs;
__device__ __forceinline__ KArgs kargs() { KArgs p = (KArgs)__builtin_amdgcn_kernarg_segment_ptr(); asm volatile("" : "+s"(p)); return p; }
struct TeamOrder {
    int nN, x, r, n, rev, alocal;
    __device__ __forceinline__ bool next(int i, pg8::Unit& u) const {
        const int L = i * n + r; if (L >= 64 * nN) return false;
        const int nig = 8 * nN, gid = L / nig, w = L % nig; int m = gid * 8 + (w & 7); if (rev) m = 63 - m;
        u.pm = team_tile(m, x); u.pn = w >> 3; u.pa = alocal ? m : u.pm; return true;
    }
    __device__ __forceinline__ void a_ready(const pg8::Unit&) const {}
    __device__ __forceinline__ void done(const pg8::Unit&) const {}
};
#define TB_WORD(x) (4096 + 128 * (x))
#define ID_WORD(b) (8192 + (b))
__device__ __forceinline__ void team_barrier(unsigned* bar, int x, unsigned n) {
    asm volatile("s_waitcnt vmcnt(0)" ::: "memory");
    __syncthreads();
    if (threadIdx.x == 0) {
        __builtin_amdgcn_s_waitcnt(0);
        unsigned* tb = bar + TB_WORD(x);
        const unsigned old = xb_add(&tb[0], 1u), gen = old / n;
        if (old + 1u == (gen + 1u) * n) xb_add(&tb[64], 1u);
        else XB_SPIN(xb_ld(&tb[64]) == gen, bar);
        __builtin_amdgcn_fence(__ATOMIC_ACQUIRE, "agent");
        asm volatile("s_waitcnt vmcnt(0)" ::: "memory");
    }
    __syncthreads();
}
#ifndef PH
#define PH 0xffff
#endif
#ifndef DBL
#define DBL 0
#endif
#define REP(bit) _Pragma("unroll 1") for (int rep_ = 0; rep_ < (((DBL) & (bit)) ? 2 : 1); ++rep_)
__global__ void __launch_bounds__(NTHREADS, 2) fwd_megakernel(Args a_unused) {
    extern __shared__ __attribute__((aligned(16))) unsigned char lds_raw[];
    cg::grid_group grid = cg::this_grid();
    volatile LAS unsigned* const bst = (volatile LAS unsigned*)((LAS unsigned char*)lds_raw + 131072 + 64);
    if (threadIdx.x < 3) bst[threadIdx.x] = 0u;
    __syncthreads();
    (void)xcd_barrier_post((unsigned*)(kargs()->ws + WS_BAR), bst);
    if (threadIdx.x == 0) ((unsigned*)(kargs()->ws + WS_BAR))[ID_WORD(blockIdx.x)] = 1u + xb_xcc_id();
#define GSYNC() do { XcdBarrier xb_; xb_.bar = (unsigned*)(kargs()->ws + WS_BAR); xb_.x = xb_xcc_id(); xb_.st = (volatile LAS unsigned*)((LAS unsigned char*)lds_raw + 131072 + 64); xcd_barrier(xb_); } while (0)
#define TEAM_OK() (((volatile LAS unsigned*)((LAS unsigned char*)lds_raw + 131072 + 64))[2] != 0u)
#define TSYNC() do { if (TEAM_OK()) team_barrier((unsigned*)(kargs()->ws + WS_BAR), (int)(blockIdx.x & 7), gridDim.x >> 3); else GSYNC(); } while (0)
#define LDSP ((LAS unsigned char*)lds_raw)
#define FRAME() const KArgs A = kargs(); int tid_l = threadIdx.x; asm volatile("" : "+v"(tid_l)); const int lane = tid_l & 63, wave = __builtin_amdgcn_readfirstlane(tid_l >> 6); const int G = gridDim.x, bx = blockIdx.x; \
    const int vcu = (G % 8 == 0) ? (bx % 8) * (G / 8) + bx / 8 : bx; const int gw = vcu * NWAVES + wave, NGW = G * NWAVES; unsigned char* const ws = A->ws; const int tx = bx & 7, tr = bx >> 3, tn = G >> 3, wv = tr * NWAVES + wave, nwv = tn * NWAVES; (void)lane; (void)gw; (void)NGW; (void)ws; (void)vcu; (void)tx; (void)tr; (void)tn; (void)wv; (void)nwv
#define LAYER() const float* const modl = (const float*)(ws + WS_MOD) + (size_t)l * NBATCH * NMOD; unsigned char* const wl = ws + WS_W + l * W_LAYER; (void)modl; (void)wl
#if PH & 1
    REP(1)
    { FRAME(); phase_prologue(*A, LDSP, gw, NGW, wave, lane); __syncthreads(); }
#endif
    grid.sync();
    {
        const unsigned* ids = (const unsigned*)(kargs()->ws + WS_BAR) + ID_WORD(0); const int G_ = gridDim.x; int ok = (G_ % 8 == 0) && (G_ <= NTHREADS);
        if ((int)threadIdx.x < G_ && ok) ok = __hip_atomic_load(ids + threadIdx.x, __ATOMIC_RELAXED, __HIP_MEMORY_SCOPE_AGENT) == __hip_atomic_load(ids + (threadIdx.x & 7), __ATOMIC_RELAXED, __HIP_MEMORY_SCOPE_AGENT);
        ok = __syncthreads_and(ok);
        if (threadIdx.x == 0) ((volatile LAS unsigned*)((LAS unsigned char*)lds_raw + 131072 + 64))[2] = ok ? 1u : 0u;
        __syncthreads();
    }
#if PH & 2
    { FRAME(); phase_mod_final(*A); }
#endif
    GSYNC();
#pragma unroll 1
    for (int l = 0; l < NLAYER; ++l) {
#if PH & 4
        REP(4)
        { FRAME(); LAYER();
          if (l == 0) phase_norm<false>(A->xp, A->xs - (size_t)NTP * 1024, nullptr, A->g_mix + l * 1024, modl + 0 * 1024, modl + 1 * 1024, (bf16*)(ws + WS_H), tx, wv, nwv, lane, (7 * l + 0) & 1);
          else phase_norm<true>(nullptr, nullptr, (const bf16*)A->out, A->g_mix + l * 1024, modl + 0 * 1024, modl + 1 * 1024, (bf16*)(ws + WS_H), tx, wv, nwv, lane, (7 * l + 0) & 1); }
#endif
        TSYNC();
#if PH & 8
        REP(8)
        { FRAME(); LAYER(); pg8::Gemm g{(const bf16*)(ws + WS_H), (const bf16*)(wl + W_IN), NTOK, NPROJ, 1024}; const TeamOrder S{NPROJ / 256, tx, tr, tn, (7 * l + 1) & 1, 0};
          pg8::EpiProj E{ws, A->q_gain + l * 64, A->k_gain + l * 64};
          pg8::gemm_phase<pg8::EpiProj, TeamOrder, true, true>(LDSP, g, S, E); }
#endif
        TSYNC();
#if PH & 16
        REP(16)
        { FRAME(); phase_attn(A->q_gain + l * 64, A->k_gain + l * 64, (const bf16*)(ws + WS_F + tx * pg8::TEAM_SLICE + pg8::TS_Q), (const bf16*)(ws + WS_F + tx * pg8::TEAM_SLICE + pg8::TS_K), (const bf16*)(ws + WS_F + tx * pg8::TEAM_SLICE + pg8::TS_V), (bf16*)(ws + WS_H), (char*)lds_raw, tx, tr, tn, lane, (7 * l + 2) & 1); }
#endif
#if PH & 32
        REP(32)
        { FRAME(); phase_conv((const bf16*)(ws + WS_F + tx * pg8::TEAM_SLICE + pg8::TS_BG), (const bf16*)(ws + WS_F + tx * pg8::TEAM_SLICE + pg8::TS_CU), A->conv_w + l * 3 * 512, (bf16*)(ws + WS_H), tx, wv, nwv, lane, (7 * l + 2) & 1); }
#endif
        TSYNC();
#if PH & 64
        { FRAME(); LAYER();
          pg8::Gemm g{(const bf16*)(ws + WS_H), (const bf16*)(wl + W_OUT), NTOK, 1024, 1024}; const TeamOrder S{4, tx, tr, tn, (7 * l + 3) & 1, 0};
          pg8::EpiResid E{A->xp, A->xs - (size_t)NTP * 1024, (bf16*)A->out, modl + 2 * 1024, l == 0 ? 1 : 0};
          pg8::gemm_phase<pg8::EpiResid, TeamOrder, true, true>(LDSP, g, S, E); }
#endif
        TSYNC();
#if PH & 128
        REP(128)
        { FRAME(); LAYER(); phase_norm<true>(nullptr, nullptr, (const bf16*)A->out, A->g_ffn + l * 1024, modl + 3 * 1024, modl + 4 * 1024, (bf16*)(ws + WS_H), tx, wv, nwv, lane, (7 * l + 4) & 1); }
#endif
        TSYNC();
#if PH & 256
        REP(256)
        { FRAME(); LAYER(); pg8::Gemm g{(const bf16*)(ws + WS_H), (const bf16*)(wl + W_GU), NTOK, 2 * DFF, 1024}; const TeamOrder S{2 * DFF / 256, tx, tr, tn, (7 * l + 5) & 1, 0};
          pg8::EpiSwiglu E{ws};
          pg8::gemm_phase<pg8::EpiSwiglu, TeamOrder, true, true>(LDSP, g, S, E); }
#endif
        TSYNC();
#if PH & 512
        { FRAME(); LAYER(); pg8::Gemm g{(const bf16*)(ws + WS_F + tx * pg8::TEAM_SLICE), (const bf16*)(wl + W_DN), NTOK, 1024, DFF}; const TeamOrder S{4, tx, tr, tn, (7 * l + 6) & 1, 1};
          pg8::EpiResid E{nullptr, nullptr, (bf16*)A->out, modl + 5 * 1024, 0};
          pg8::gemm_phase<pg8::EpiResid, TeamOrder, true, true>(LDSP, g, S, E); }
#endif
        TSYNC();
    }
#if PH & 1024
    { FRAME(); phase_final_norm(A->out, A->g_final, tx, wv, nwv, lane); }
#endif
}

extern "C" void kernel_launch(void* const* d_in, const int* in_sizes, int n_in, void* d_out, int out_size, void* d_ws, size_t ws_size, hipStream_t stream) {
    static int grid = 0;
    if (grid == 0) {
        if (n_in != 17 || out_size != NTOK * 1024 || ws_size < WS_END) { fprintf(stderr, "kernel_launch: unexpected problem (n_in %d, out %d, ws %zu, need %zu)\n", n_in, out_size, ws_size, (size_t)WS_END); grid = -1; return; }
        int dev = 0, cus = 0, per_cu = 0;
        hipGetDevice(&dev); hipDeviceGetAttribute(&cus, hipDeviceAttributeMultiprocessorCount, dev);
        if (hipFuncSetAttribute((const void*)fwd_megakernel, hipFuncAttributeMaxDynamicSharedMemorySize, LDS_TOTAL) != hipSuccess) { fprintf(stderr, "kernel_launch: hipFuncSetAttribute failed\n"); grid = -1; return; }
        if (hipOccupancyMaxActiveBlocksPerMultiprocessor(&per_cu, (const void*)fwd_megakernel, NTHREADS, LDS_TOTAL) != hipSuccess || per_cu < 1) { fprintf(stderr, "kernel_launch: occupancy query failed (%d)\n", per_cu); (void)hipGetLastError(); per_cu = 1; }
        grid = cus * per_cu;
        if (grid > 256) grid = 256;
        if (grid % 8 != 0 || grid < 8) { fprintf(stderr, "kernel_launch: grid %d is not a multiple of 8 (the layer loop is organised in 8 teams)\n", grid); grid = -1; return; }
        fprintf(stderr, "kernel_launch: grid %d (cus %d, per_cu %d), ws %zu\n", grid, cus, per_cu, ws_size);
    }
    if (grid < 0) return;
    Args a{};
    a.xp = (const float*)d_in[0]; a.xs = (const float*)d_in[1]; a.cp = (const float*)d_in[2]; a.cs = (const float*)d_in[3];
    a.w_mod = (const float*)d_in[4]; a.b_mod = (const float*)d_in[5]; a.g_mix = (const float*)d_in[6]; a.w_in = (const float*)d_in[7];
    a.q_gain = (const float*)d_in[8]; a.k_gain = (const float*)d_in[9]; a.conv_w = (const float*)d_in[10]; a.w_out = (const float*)d_in[11];
    a.g_ffn = (const float*)d_in[12]; a.w_gate = (const float*)d_in[13]; a.w_up = (const float*)d_in[14]; a.w_down = (const float*)d_in[15]; a.g_final = (const float*)d_in[16];
    a.out = (float*)d_out; a.ws = (unsigned char*)d_ws; a.G = grid; a.pad = 0;
    if (hipMemsetAsync((char*)d_ws + WS_BAR, 0, WS_BAR_BYTES, stream) != hipSuccess) { fprintf(stderr, "kernel_launch: memset failed\n"); return; }
    void* args[] = {&a};
    hipError_t e = hipLaunchCooperativeKernel((const void*)fwd_megakernel, dim3(grid), dim3(NTHREADS), args, LDS_TOTAL, stream);
    if (e != hipSuccess) fprintf(stderr, "kernel_launch: cooperative launch failed: %s (grid %d)\n", hipGetErrorString(e), grid);
}
```

```cpp
#include <hip/hip_runtime.h>
#include <hip/hip_cooperative_groups.h>
#include <hip/hip_bf16.h>
#include <cstdio>
#include <cstdint>
#include <cmath>
namespace cg = cooperative_groups;
namespace pg8 {
#define PG8_LAS __attribute__((address_space(3)))
typedef unsigned short bf16_t;
typedef short bf16x8 __attribute__((ext_vector_type(8)));
typedef float f32x4 __attribute__((ext_vector_type(4)));
typedef unsigned u32x4 __attribute__((ext_vector_type(4)));
constexpr int BM = 256, BK = 64, HALF = 128, HTB = HALF * BK * 2  , STAGE_BYTES = 8 * HTB, NXCD = 8, WGM = 8;

__host__ __device__ __forceinline__ int lds_byte(int r, int c) { const int st = (r >> 4) * 2 + (c >> 5), rr = r & 15, cc = c & 31, ob = rr * 64 + cc * 2; return st * 1024 + (ob ^ (((ob >> 9) & 1) << 5)); }
__host__ __device__ __forceinline__ void stage_rc(int b, int& R, int& C) { const int st = b / 1024, sb = b % 1024, swz = sb ^ (((sb >> 9) & 1) << 5); R = (st >> 1) * 16 + swz / 64; C = (st & 1) * 32 + (swz % 64) / 2; }
__host__ __device__ __forceinline__ int perm32(int rho) { const int n = rho >> 4, i = rho & 15; return 8 * (i >> 2) + 4 * n + (i & 3); }

struct Unit { int pm, pn; };
struct Gemm { const bf16_t* A; const bf16_t* Bt; int M, N, K; };

struct StaticOrder {
    int nM, nN, nwg, G, c, rev;
    __host__ __device__ void init(int M, int N, int G_, int c_, int rev_ = 0) { nM = M / BM; nN = N / BM; nwg = nM * nN; G = G_; c = c_; rev = rev_; }
    __host__ __device__ bool next(int i, Unit& u) const {
        const long L = (long)i * G + c; if (L >= nwg) return false;
        int wgid = (int)L; { const int q = nwg / NXCD, r = nwg % NXCD, xcd = wgid % NXCD, off = wgid / NXCD; wgid = (xcd < r ? xcd * (q + 1) : r * (q + 1) + (xcd - r) * q) + off; }
        const int nig = WGM * nN, gid = wgid / nig, fm = gid * WGM, gsz = (nM - fm) < WGM ? (nM - fm) : WGM;
        u.pm = fm + ((wgid % nig) % gsz); u.pn = (wgid % nig) / gsz; if (rev) u.pm = nM - 1 - u.pm; return true;
    }
    __device__ __forceinline__ void a_ready(const Unit&) const {}
    __device__ __forceinline__ void done(const Unit&) const {}
};

__device__ __forceinline__ unsigned cvt_pk_bf16(float lo, float hi) { unsigned r; asm volatile("v_cvt_pk_bf16_f32 %0, %1, %2" : "=v"(r) : "v"(lo), "v"(hi)); return r; }
typedef float f32x2 __attribute__((ext_vector_type(2)));
constexpr size_t PMiB = 1u << 20, PWS_ROT = 0, PWS_Q = 308 * PMiB, PWS_K = PWS_Q + 128 * PMiB, PWS_V = PWS_K + 32 * PMiB, PWS_BG = PWS_V + 32 * PMiB, PWS_CU = PWS_BG + 128 * PMiB;
constexpr float QK_EPS = 1e-6f;
constexpr float ATT_C2 = 0.125f * 1.4426950408889634f;

struct EpiProj {
    static constexpr bool PERM = true, AFTER_DRAIN = false;
    unsigned char* ws; const float* qg; const float* kg;
    __device__ __forceinline__ void operator()(const f32x4 (&acc)[2][2][4][2], const Unit& u, int wr, int wc, int fr, int fq) const {
        const int pn = u.pn; const int row0 = u.pm * BM + wr * 64 + fr;
        bf16_t* const Q = (bf16_t*)(ws + PWS_Q); bf16_t* const Kb = (bf16_t*)(ws + PWS_K); bf16_t* const Vb = (bf16_t*)(ws + PWS_V); bf16_t* const Bg = (bf16_t*)(ws + PWS_BG); bf16_t* const CU = (bf16_t*)(ws + PWS_CU); const float* const rot = (const float*)(ws + PWS_ROT);
        if (pn >= 5) {
            bf16_t* base = CU + (size_t)row0 * 512 + (pn - 5) * 128 + wc * 32 + fq * 8;
#pragma unroll
            for (int ai = 0; ai < 2; ++ai)
#pragma unroll
                for (int m = 0; m < 4; ++m) { const f32x4 v0 = acc[ai][0][m][0] * acc[ai][1][m][0], v1 = acc[ai][0][m][1] * acc[ai][1][m][1];
                    u32x4 w; w.x = cvt_pk_bf16(v0[0], v0[1]); w.y = cvt_pk_bf16(v0[2], v0[3]); w.z = cvt_pk_bf16(v1[0], v1[1]); w.w = cvt_pk_bf16(v1[2], v1[3]);
                    *(u32x4*)(base + (size_t)(ai * HALF + m * 16) * 512) = w; }
            return;
        }
        const bool is_q = pn < 2, is_k = (pn == 2) && (wc < 2), is_v = (pn == 2) && (wc >= 2);
        bf16_t* base; int pitch;
        if (is_q) { base = Q + pn * 256 + wc * 64; pitch = 512; }
        else if (is_k) { base = Kb + wc * 64; pitch = 128; }
        else if (is_v) { base = Vb + (wc - 2) * 64; pitch = 128; }
        else { base = Bg + (pn - 3) * 256 + wc * 64; pitch = 512; }
        base += (size_t)row0 * pitch + fq * 8;
        if (is_q || is_k) {
            const float* gp = (is_q ? qg : kg) + fq * 8; const float osc = is_q ? ATT_C2 : 1.0f;
            f32x4 gv[2][2];
#pragma unroll
            for (int bj = 0; bj < 2; ++bj)
#pragma unroll
                for (int n = 0; n < 2; ++n) gv[bj][n] = *(const f32x4*)(gp + bj * 32 + n * 4) * osc;
#pragma unroll
            for (int ai = 0; ai < 2; ++ai)
#pragma unroll
                for (int m = 0; m < 4; ++m) {
                    float ss = 0.f;
#pragma unroll
                    for (int bj = 0; bj < 2; ++bj)
#pragma unroll
                        for (int n = 0; n < 2; ++n) { const f32x4 x = acc[ai][bj][m][n]; ss += (x[0] * x[0] + x[1] * x[1]) + (x[2] * x[2] + x[3] * x[3]); }
                    ss += __shfl_xor(ss, 16); ss += __shfl_xor(ss, 32);
                    const float rstd = __builtin_amdgcn_rsqf(ss * (1.0f / 64.0f) + QK_EPS);
                    const int t = row0 + ai * HALF + m * 16;
                    const int prow = (t < 65536) ? ((t >> 6) & 127) : ((t >> 6) & 63), pcol = t & 63;
#pragma unroll
                    for (int bj = 0; bj < 2; ++bj) {
                        const float* rp = rot + ((bj ? pcol : prow) * 16 + fq * 4) * 2;
                        f32x4 o[2];
#pragma unroll
                        for (int n = 0; n < 2; ++n) { const f32x4 cs = *(const f32x4*)(rp + n * 4); const f32x4 x = acc[ai][bj][m][n] * rstd * gv[bj][n];
                            o[n][0] = x[0] * cs[0] - x[1] * cs[1]; o[n][1] = x[0] * cs[1] + x[1] * cs[0]; o[n][2] = x[2] * cs[2] - x[3] * cs[3]; o[n][3] = x[2] * cs[3] + x[3] * cs[2]; }
                        u32x4 w; w.x = cvt_pk_bf16(o[0][0], o[0][1]); w.y = cvt_pk_bf16(o[0][2], o[0][3]); w.z = cvt_pk_bf16(o[1][0], o[1][1]); w.w = cvt_pk_bf16(o[1][2], o[1][3]);
                        *(u32x4*)(base + (size_t)(ai * HALF + m * 16) * pitch + bj * 32) = w; }
                }
        } else {
#pragma unroll
            for (int ai = 0; ai < 2; ++ai)
#pragma unroll
                for (int m = 0; m < 4; ++m)
#pragma unroll
                    for (int bj = 0; bj < 2; ++bj) { const f32x4 v0 = acc[ai][bj][m][0], v1 = acc[ai][bj][m][1];
                        u32x4 w; w.x = cvt_pk_bf16(v0[0], v0[1]); w.y = cvt_pk_bf16(v0[2], v0[3]); w.z = cvt_pk_bf16(v1[0], v1[1]); w.w = cvt_pk_bf16(v1[2], v1[3]);
                        *(u32x4*)(base + (size_t)(ai * HALF + m * 16) * pitch + bj * 32) = w; }
        }
    }
};
struct EpiResid {
    static constexpr bool PERM = true, AFTER_DRAIN = false;
    const float* xa; const float* xb; bf16_t* res; const float* gate; int in_f32;
    __device__ __forceinline__ void operator()(const f32x4 (&acc)[2][2][4][2], const Unit& u, int wr, int wc, int fr, int fq) const {
        const int rowt = u.pm * BM; const int b = rowt < 65536 ? (rowt >> 13) : 8 + ((rowt - 65536) >> 12);
        const float* xin = rowt < 65536 ? xa : xb;
        const int row0 = rowt + wr * 64 + fr, col0 = u.pn * BM + wc * 32 + fq * 8;
        f32x4 gv[2][2];
#pragma unroll
        for (int bj = 0; bj < 2; ++bj)
#pragma unroll
            for (int n = 0; n < 2; ++n) gv[bj][n] = *(const f32x4*)(gate + (size_t)b * 6144 + col0 + bj * HALF + n * 4);
        if (in_f32) {
#pragma unroll
            for (int ai = 0; ai < 2; ++ai)
#pragma unroll
                for (int mp = 0; mp < 2; ++mp) { f32x4 x[2][2][2];
#pragma unroll
                    for (int mm = 0; mm < 2; ++mm)
#pragma unroll
                        for (int bj = 0; bj < 2; ++bj) { const float* p = xin + (size_t)(row0 + ai * HALF + (2 * mp + mm) * 16) * 1024 + col0 + bj * HALF; x[mm][bj][0] = *(const f32x4*)p; x[mm][bj][1] = *(const f32x4*)(p + 4); }
#pragma unroll
                    for (int mm = 0; mm < 2; ++mm)
#pragma unroll
                        for (int bj = 0; bj < 2; ++bj) { const int m = 2 * mp + mm; const f32x4 y0 = x[mm][bj][0] + gv[bj][0] * acc[ai][bj][m][0], y1 = x[mm][bj][1] + gv[bj][1] * acc[ai][bj][m][1];
                            u32x4 w; w.x = cvt_pk_bf16(y0[0], y0[1]); w.y = cvt_pk_bf16(y0[2], y0[3]); w.z = cvt_pk_bf16(y1[0], y1[1]); w.w = cvt_pk_bf16(y1[2], y1[3]);
                            *(u32x4*)(res + (size_t)(row0 + ai * HALF + m * 16) * 2048 + col0 + bj * HALF) = w; }
                    asm volatile("" ::: "memory"); }
        } else {
#pragma unroll
            for (int ai = 0; ai < 2; ++ai) { u32x4 p[4][2];
#pragma unroll
                for (int m = 0; m < 4; ++m)
#pragma unroll
                    for (int bj = 0; bj < 2; ++bj) p[m][bj] = *(const u32x4*)(res + (size_t)(row0 + ai * HALF + m * 16) * 2048 + col0 + bj * HALF);
#pragma unroll
                for (int m = 0; m < 4; ++m)
#pragma unroll
                    for (int bj = 0; bj < 2; ++bj) { const u32x4 q = p[m][bj];
                        const f32x4 x0 = (f32x4){__uint_as_float(q.x << 16), __uint_as_float(q.x & 0xffff0000u), __uint_as_float(q.y << 16), __uint_as_float(q.y & 0xffff0000u)};
                        const f32x4 x1 = (f32x4){__uint_as_float(q.z << 16), __uint_as_float(q.z & 0xffff0000u), __uint_as_float(q.w << 16), __uint_as_float(q.w & 0xffff0000u)};
                        const f32x4 y0 = x0 + gv[bj][0] * acc[ai][bj][m][0], y1 = x1 + gv[bj][1] * acc[ai][bj][m][1];
                        u32x4 w; w.x = cvt_pk_bf16(y0[0], y0[1]); w.y = cvt_pk_bf16(y0[2], y0[3]); w.z = cvt_pk_bf16(y1[0], y1[1]); w.w = cvt_pk_bf16(y1[2], y1[3]);
                        *(u32x4*)(res + (size_t)(row0 + ai * HALF + m * 16) * 2048 + col0 + bj * HALF) = w; }
                asm volatile("" ::: "memory"); }
        }
    }
};
struct EpiSwiglu {
    static constexpr bool PERM = true, AFTER_DRAIN = false;
    bf16_t* Hd;
    __device__ __forceinline__ void operator()(const f32x4 (&acc)[2][2][4][2], const Unit& u, int wr, int wc, int fr, int fq) const {
        bf16_t* base = Hd + (size_t)(u.pm * BM + wr * 64 + fr) * 2816 + u.pn * 128 + wc * 32 + fq * 8;
#pragma unroll
        for (int ai = 0; ai < 2; ++ai)
#pragma unroll
            for (int m = 0; m < 4; ++m) { f32x4 o[2];
#pragma unroll
                for (int n = 0; n < 2; ++n) { const f32x4 g = acc[ai][0][m][n], up = acc[ai][1][m][n];
#pragma unroll
                    for (int e = 0; e < 4; ++e) { const float ex = __builtin_amdgcn_exp2f(g[e] * -1.4426950408889634f); o[n][e] = g[e] * __builtin_amdgcn_rcpf(1.0f + ex) * up[e]; } }
                u32x4 w; w.x = cvt_pk_bf16(o[0][0], o[0][1]); w.y = cvt_pk_bf16(o[0][2], o[0][3]); w.z = cvt_pk_bf16(o[1][0], o[1][1]); w.w = cvt_pk_bf16(o[1][2], o[1][3]);
                *(u32x4*)(base + (size_t)(ai * HALF + m * 16) * 2816) = w; }
    }
};
template <class Epi, class Sched, bool ALIGN_EPI = false, bool SP2 = false>
__device__ __forceinline__ void gemm_phase(PG8_LAS unsigned char* lds, const Gemm g, const Sched& S, const Epi& E) {
    int tid_l = threadIdx.x; asm volatile("" : "+v"(tid_l));
    const int tid = tid_l, wid = __builtin_amdgcn_readfirstlane(tid >> 6), lane = tid & 63, wr = wid >> 2, wc = wid & 3, fr = lane & 15, fq = lane >> 4;
    const int K = g.K, nt = K / BK;
    unsigned voffA[2], voffB[2];
#pragma unroll
    for (int i = 0; i < 2; ++i) { int R, C; stage_rc(tid * 16 + i * 8192, R, C); const int Rb = Epi::PERM ? ((R & ~31) + perm32(R & 31)) : R;
        voffA[i] = (unsigned)(R * K + C) * 2u; voffB[i] = (unsigned)(Rb * K + C) * 2u; }
    const size_t kstep = (size_t)(BK * 2);
    const size_t hstep = (size_t)HALF * K * 2;
    const size_t tstep = 2 * hstep;
    const unsigned ldsw = (unsigned)wid * 1024u;
    const int aoff = lds_byte(wr * 64 + fr, fq * 8), boff = lds_byte(wc * 32 + fr, fq * 8);
#define PG8_SA(b, h) (((b) * 2 + (h)) * HTB)
#define PG8_SB(b, h) ((4 + (b) * 2 + (h)) * HTB)
#define PG8_STAGE(bufoff, gbase, voff) do { _Pragma("unroll") for (int _i = 0; _i < 2; ++_i) \
        __builtin_amdgcn_global_load_lds((const unsigned*)((const char*)(gbase) + (voff)[_i]), (PG8_LAS unsigned*)(lds + (bufoff) + ldsw + _i * 8192), 16, 0, 0); } while (0)
#define PG8_LDA(dst, b, h) do { _Pragma("unroll") for (int m = 0; m < 4; ++m) _Pragma("unroll") for (int k = 0; k < 2; ++k) dst[m][k] = *(const PG8_LAS bf16x8*)(lds + PG8_SA(b, h) + aoff + m * 2048 + k * 1024); } while (0)
#define PG8_LDB(dst, b, h) do { _Pragma("unroll") for (int n = 0; n < 2; ++n) _Pragma("unroll") for (int k = 0; k < 2; ++k) dst[n][k] = *(const PG8_LAS bf16x8*)(lds + PG8_SB(b, h) + boff + n * 2048 + k * 1024); } while (0)
#define PG8_MMA(ai, bj, At, Bt) do { __builtin_amdgcn_s_setprio(1); _Pragma("unroll") for (int m = 0; m < 4; ++m) _Pragma("unroll") for (int n = 0; n < 2; ++n) _Pragma("unroll") for (int k = 0; k < 2; ++k) \
        acc[ai][bj][m][n] = __builtin_amdgcn_mfma_f32_16x16x32_bf16(Bt[n][k], At[m][k], acc[ai][bj][m][n], 0, 0, 0); __builtin_amdgcn_s_setprio(0); } while (0)
#define PG8_WAIT_V(n) asm volatile("s_waitcnt vmcnt(" #n ")" ::: "memory")
#define PG8_WAIT_L(n) asm volatile("s_waitcnt lgkmcnt(" #n ")" ::: "memory")
#define PG8_BAR __builtin_amdgcn_s_barrier()
#define PG8_SCHED __builtin_amdgcn_sched_barrier(0)
    Unit cur, nxt; int ui = 0;
    if (!S.next(0, cur)) return;
    f32x4 acc[2][2][4][2];
#pragma unroll
    for (int a = 0; a < 2; ++a)
#pragma unroll
        for (int b = 0; b < 2; ++b)
#pragma unroll
            for (int m = 0; m < 4; ++m)
#pragma unroll
                for (int n = 0; n < 2; ++n) acc[a][b][m][n] = (f32x4){0.f, 0.f, 0.f, 0.f};
    bf16x8 At[4][2], B0[2][2], B1[2][2];
    const char* cA = (const char*)g.A + (size_t)cur.pm * tstep; const char* cB = (const char*)g.Bt + (size_t)cur.pn * tstep;
    S.a_ready(cur);
    if constexpr (SP2) {
        PG8_STAGE(PG8_SB(0, 0), cB, voffB); PG8_STAGE(PG8_SB(0, 1), cB + hstep, voffB); PG8_STAGE(PG8_SA(0, 0), cA, voffA); PG8_STAGE(PG8_SA(0, 1), cA + hstep, voffA);
        if (wr == 1) PG8_BAR;
        PG8_WAIT_V(2); PG8_BAR;
        PG8_STAGE(PG8_SB(1, 0), cB + kstep, voffB); PG8_STAGE(PG8_SA(1, 0), cA + kstep, voffA); PG8_STAGE(PG8_SB(1, 1), cB + hstep + kstep, voffB);
        PG8_WAIT_V(6); PG8_BAR;
    } else {
        PG8_STAGE(PG8_SB(0, 0), cB, voffB); PG8_STAGE(PG8_SA(0, 0), cA, voffA); PG8_STAGE(PG8_SB(0, 1), cB + hstep, voffB); PG8_STAGE(PG8_SA(0, 1), cA + hstep, voffA);
        if (wr == 1) PG8_BAR;
        PG8_WAIT_V(4); PG8_BAR;
        PG8_STAGE(PG8_SB(1, 0), cB + kstep, voffB); PG8_STAGE(PG8_SA(1, 0), cA + kstep, voffA); PG8_STAGE(PG8_SB(1, 1), cB + hstep + kstep, voffB);
        PG8_WAIT_V(6); PG8_BAR;
    }
    for (;;) {
        const bool has_next = S.next(ui + 1, nxt);
        const char* nA = has_next ? (const char*)g.A + (size_t)nxt.pm * tstep : cA; const char* nB = has_next ? (const char*)g.Bt + (size_t)nxt.pn * tstep : cB;
        for (int t = 0; t < nt; t += 2) {
            const bool last = (t == nt - 2);
            const char* a1 = cA + (size_t)(t + 1) * kstep;
            const char* a2 = last ? nA : cA + (size_t)(t + 2) * kstep; const char* b2 = last ? nB : cB + (size_t)(t + 2) * kstep;
            const char* a3 = a2 + kstep; const char* b3 = b2 + kstep;
            if (last && has_next) S.a_ready(nxt);
            if constexpr (SP2) {
            PG8_LDB(B0, 0, 0); PG8_LDB(B1, 0, 1); PG8_SCHED; PG8_LDA(At, 0, 0); PG8_STAGE(PG8_SA(1, 1), a1 + hstep, voffA);
            PG8_WAIT_V(8); PG8_WAIT_L(0); PG8_BAR; PG8_MMA(0, 0, At, B0); PG8_MMA(0, 1, At, B1); PG8_BAR; PG8_SCHED;
            PG8_LDA(At, 0, 1); PG8_STAGE(PG8_SB(0, 0), b2, voffB); PG8_STAGE(PG8_SB(0, 1), b2 + hstep, voffB); PG8_STAGE(PG8_SA(0, 0), a2, voffA);
            PG8_WAIT_V(8); PG8_WAIT_L(0); PG8_BAR; PG8_MMA(1, 0, At, B0); PG8_MMA(1, 1, At, B1); PG8_BAR; PG8_SCHED;
            PG8_LDB(B0, 1, 0); PG8_LDB(B1, 1, 1); PG8_SCHED; PG8_LDA(At, 1, 0); PG8_STAGE(PG8_SA(0, 1), a2 + hstep, voffA);
            PG8_WAIT_V(8); PG8_WAIT_L(0); PG8_BAR; PG8_MMA(0, 0, At, B0); PG8_MMA(0, 1, At, B1); PG8_BAR; PG8_SCHED;
            PG8_LDA(At, 1, 1); PG8_STAGE(PG8_SB(1, 0), b3, voffB); PG8_STAGE(PG8_SB(1, 1), b3 + hstep, voffB); PG8_STAGE(PG8_SA(1, 0), a3, voffA);
            PG8_WAIT_V(8); PG8_WAIT_L(0); PG8_BAR; PG8_MMA(1, 0, At, B0); PG8_MMA(1, 1, At, B1); PG8_BAR; PG8_SCHED;
            } else {
            PG8_LDB(B0, 0, 0); PG8_SCHED; PG8_LDA(At, 0, 0); PG8_STAGE(PG8_SA(1, 1), a1 + hstep, voffA);
            PG8_WAIT_L(8); PG8_BAR; PG8_WAIT_L(0); PG8_MMA(0, 0, At, B0); PG8_BAR; PG8_SCHED;
            PG8_LDB(B1, 0, 1); PG8_STAGE(PG8_SB(0, 0), b2, voffB);
            PG8_BAR; PG8_WAIT_L(0); PG8_MMA(0, 1, At, B1); PG8_BAR;
            PG8_LDA(At, 0, 1); PG8_STAGE(PG8_SA(0, 0), a2, voffA);
            PG8_BAR; PG8_WAIT_L(0); PG8_MMA(1, 0, At, B0); PG8_BAR; PG8_SCHED;
            PG8_STAGE(PG8_SB(0, 1), b2 + hstep, voffB);
            PG8_WAIT_V(6); PG8_BAR; PG8_MMA(1, 1, At, B1); PG8_BAR;
            PG8_LDB(B0, 1, 0); PG8_SCHED; PG8_LDA(At, 1, 0); PG8_STAGE(PG8_SA(0, 1), a2 + hstep, voffA);
            PG8_WAIT_L(8); PG8_BAR; PG8_WAIT_L(0); PG8_MMA(0, 0, At, B0); PG8_BAR; PG8_SCHED;
            PG8_LDB(B1, 1, 1); PG8_STAGE(PG8_SB(1, 0), b3, voffB);
            PG8_BAR; PG8_WAIT_L(0); PG8_MMA(0, 1, At, B1); PG8_BAR;
            PG8_LDA(At, 1, 1); PG8_STAGE(PG8_SA(1, 0), a3, voffA);
            PG8_BAR; PG8_WAIT_L(0); PG8_MMA(1, 0, At, B0); PG8_BAR; PG8_SCHED;
            PG8_STAGE(PG8_SB(1, 1), b3 + hstep, voffB);
            PG8_WAIT_V(6); PG8_BAR; PG8_MMA(1, 1, At, B1); PG8_BAR;
            }
        }
        if constexpr (ALIGN_EPI) { if (wr == 0) PG8_BAR; }
        if constexpr (!Epi::AFTER_DRAIN) { E(acc, cur, wr, wc, fr, fq); S.done(cur); }
        if (!has_next) break;
#pragma unroll
        for (int a = 0; a < 2; ++a)
#pragma unroll
            for (int b = 0; b < 2; ++b)
#pragma unroll
                for (int m = 0; m < 4; ++m)
#pragma unroll
                    for (int n = 0; n < 2; ++n) acc[a][b][m][n] = (f32x4){0.f, 0.f, 0.f, 0.f};
        cur = nxt; cA = nA; cB = nB; ++ui;
        if constexpr (ALIGN_EPI) { if (wr == 1) PG8_BAR; }
    }
    PG8_WAIT_V(0);
    if constexpr (!ALIGN_EPI) { if (wr == 0) PG8_BAR; }
    PG8_BAR;
    if constexpr (Epi::AFTER_DRAIN) { E.fused(acc, cur, wr, wc, fr, fq, lds, wid, lane); S.done(cur); }
#undef PG8_SA
#undef PG8_SB
#undef PG8_STAGE
#undef PG8_LDA
#undef PG8_LDB
#undef PG8_MMA
#undef PG8_WAIT_V
#undef PG8_WAIT_L
#undef PG8_BAR
#undef PG8_SCHED
}
}
namespace attn_body {
using bf16=__hip_bfloat16;
using bf16x8=__attribute__((ext_vector_type(8)))short;
using s16x4=__attribute__((ext_vector_type(4)))short;
using f32x16=__attribute__((ext_vector_type(16)))float;
using u32x4=__attribute__((ext_vector_type(4)))unsigned;
constexpr int D=64,QP=512,KP=128,OP=1024;
constexpr int NW=8,QBLK=32,QB=QBLK*NW,KVBLK=64;
__device__ __forceinline__ int crow(int r,int hi){return (r&3)+8*(r>>2)+4*hi;}
#define SBAR() __builtin_amdgcn_sched_barrier(0)
constexpr int NSLOT=3, SLOTB=8192;
constexpr int LDS_K=0, LDS_V=NSLOT*SLOTB, LDS_WS=2*NSLOT*SLOTB, LDS_OST=LDS_WS+NW*64*4, LDS_BYTES=LDS_OST+NW*4096;
constexpr float C2=0.125f*1.4426950408889634f;
__device__ __forceinline__ void glds16(const void*gsrc,unsigned lds_dst){unsigned keep;
  asm volatile("s_mov_b32 %0, m0\n\ts_mov_b32 m0, %2\n\ts_nop 0\n\tglobal_load_lds_dwordx4 %1, off\n\ts_mov_b32 m0, %0":"=&s"(keep):"v"(gsrc),"s"(lds_dst):"memory");}
__device__ __forceinline__ float max3f(float a,float b,float c){float r;asm("v_max3_f32 %0, %1, %2, %3":"=v"(r):"v"(a),"v"(b),"v"(c));return r;}
__device__ __forceinline__ float max2f(float a,float b){float r;asm("v_max_f32_e32 %0, %1, %2":"=v"(r):"v"(a),"v"(b));return r;}
__device__ __forceinline__ float fadd_s(float a,float b){float r;asm("v_add_f32_e32 %0, %1, %2":"=v"(r):"v"(a),"v"(b));return r;}
__device__ __forceinline__ float fsub_s(float a,float b){float r;asm("v_sub_f32_e32 %0, %1, %2":"=v"(r):"v"(a),"v"(b));return r;}
typedef float f32x2_t __attribute__((ext_vector_type(2))); typedef __bf16 bf16x2_t __attribute__((ext_vector_type(2)));
__device__ __forceinline__ unsigned cvtpk_s(float lo,float hi){f32x2_t v={lo,hi};bf16x2_t b=__builtin_convertvector(v,bf16x2_t);return __builtin_bit_cast(unsigned,b);}
#define WAIT_BAR(N) asm volatile("s_waitcnt vmcnt(" #N ") lgkmcnt(0)\n\ts_barrier":::"memory")

__device__ __forceinline__ void qkt(f32x16&p0,f32x16&p1,const char*Kslot,const bf16x8*qr,const f32x16&negm,int r32,int hi){
  const char*kb=Kslot+hi*1024+r32*16;
  #pragma unroll
  for(int d0=0;d0<4;++d0){
    const bf16x8 b0=*reinterpret_cast<const bf16x8*>(kb+d0*2048);
    const bf16x8 b1=*reinterpret_cast<const bf16x8*>(kb+d0*2048+512);
    if(d0==0){p0=__builtin_amdgcn_mfma_f32_32x32x16_bf16(b0,qr[0],negm,0,0,0);p1=__builtin_amdgcn_mfma_f32_32x32x16_bf16(b1,qr[0],negm,0,0,0);}
    else{p0=__builtin_amdgcn_mfma_f32_32x32x16_bf16(b0,qr[d0],p0,0,0,0);p1=__builtin_amdgcn_mfma_f32_32x32x16_bf16(b1,qr[d0],p1,0,0,0);}}
}
typedef __attribute__((address_space(3))) const char* lds_cptr;
typedef short v4i16_t __attribute__((ext_vector_type(4)));
__device__ __forceinline__ void kload8(bf16x8*kf,lds_cptr kp){
  kf[0]=*(const __attribute__((address_space(3))) bf16x8*)(kp);      kf[1]=*(const __attribute__((address_space(3))) bf16x8*)(kp+512);
  kf[2]=*(const __attribute__((address_space(3))) bf16x8*)(kp+2048); kf[3]=*(const __attribute__((address_space(3))) bf16x8*)(kp+2560);
  kf[4]=*(const __attribute__((address_space(3))) bf16x8*)(kp+4096); kf[5]=*(const __attribute__((address_space(3))) bf16x8*)(kp+4608);
  kf[6]=*(const __attribute__((address_space(3))) bf16x8*)(kp+6144); kf[7]=*(const __attribute__((address_space(3))) bf16x8*)(kp+6656);
}
__device__ __forceinline__ void kload2(bf16x8*kf,lds_cptr kp,int j){ kf[2*j]=*(const __attribute__((address_space(3))) bf16x8*)(kp+j*2048); kf[2*j+1]=*(const __attribute__((address_space(3))) bf16x8*)(kp+j*2048+512); }
__device__ __forceinline__ s16x4 vtr(lds_cptr p){ return __builtin_bit_cast(s16x4,__builtin_amdgcn_ds_read_tr16_b64_v4i16((__attribute__((address_space(3))) v4i16_t*)p)); }
__device__ __forceinline__ float rowmax(const f32x16&p0,const f32x16&p1){
  float a=max3f(p0[0],p0[1],p1[0]),b=max3f(p0[2],p0[3],p1[1]);a=max3f(a,p1[2],p1[3]);
  #pragma unroll
  for(int r=4;r<16;r+=4){a=max3f(a,p0[r],p0[r+1]);b=max3f(b,p0[r+2],p0[r+3]);a=max3f(a,p1[r],p1[r+1]);b=max3f(b,p1[r+2],p1[r+3]);}
  const float m=max2f(a,b);
  auto rr=__builtin_amdgcn_permlane32_swap(__float_as_uint(m),__float_as_uint(m),false,false);
  return max2f(__uint_as_float(rr[0]),__uint_as_float(rr[1]));
}
__device__ __forceinline__ void pv(f32x16*o,int vb,bf16x8 pa0,bf16x8 pa1,bf16x8 pa2,bf16x8 pa3){
  #pragma unroll
  for(int d0=0;d0<2;++d0){s16x4 lo[4],hi[4];
    #pragma unroll
    for(int ks=0;ks<4;++ks){
      asm volatile("ds_read_b64_tr_b16 %0,%1 offset:%c2":"=&v"(lo[ks]):"v"(vb),"i"(d0*4096+ks*1024):"memory");
      asm volatile("ds_read_b64_tr_b16 %0,%1 offset:%c2":"=&v"(hi[ks]):"v"(vb),"i"(d0*4096+ks*1024+512):"memory");}
    asm volatile("s_waitcnt lgkmcnt(0)":::"memory");SBAR();
    #define PK(k) (bf16x8){lo[k][0],lo[k][1],lo[k][2],lo[k][3],hi[k][0],hi[k][1],hi[k][2],hi[k][3]}
    o[d0]=__builtin_amdgcn_mfma_f32_32x32x16_bf16(pa0,PK(0),o[d0],0,0,0);
    o[d0]=__builtin_amdgcn_mfma_f32_32x32x16_bf16(pa1,PK(1),o[d0],0,0,0);
    o[d0]=__builtin_amdgcn_mfma_f32_32x32x16_bf16(pa2,PK(2),o[d0],0,0,0);
    o[d0]=__builtin_amdgcn_mfma_f32_32x32x16_bf16(pa3,PK(3),o[d0],0,0,0);
    #undef PK
  }
}

#ifndef ATTN_STORE16
#define ATTN_STORE16(p,v) (*(u32x4*)(p)=(v))
#endif
template<int THRL,bool SREF> __device__ __forceinline__ void attn_unit(float mref,long rowbase,int S,int h,int kvh,int qb,const bf16*Q,const bf16*__restrict__ K,const bf16*__restrict__ V,bf16*O,char*shm){
  int tid_l=threadIdx.x; asm volatile("":"+v"(tid_l));
  const int tid=tid_l,lane=tid&63,r32=lane&31,hi=lane>>5; const int wid=__builtin_amdgcn_readfirstlane(tid>>6);
  const int q0=qb*QB;
  const bf16*Qw=Q+(rowbase+q0+wid*QBLK)*QP+h*D;
  const bf16*Kh=K+rowbase*KP+kvh*D,*Vh=V+rowbase*KP+kvh*D;
  const unsigned lds0=(unsigned)(uintptr_t)shm;
  float*wsf=(float*)(shm+LDS_WS)+wid*64;
  const bf16*ksrc=Kh+(long)lane*KP+wid*8;
  const bf16*vsrc=Vh+(long)(16*(wid&3)+(lane>>2))*KP+(wid>>2)*32+(lane&3)*8;
  const unsigned kdst=lds0+LDS_K+wid*1024, vdst=lds0+LDS_V+wid*1024;
  #define DMA_K(t,slot) glds16(ksrc+(long)(t)*KVBLK*KP,(unsigned)__builtin_amdgcn_readfirstlane(kdst+(slot)))
  #define DMA_V(t,slot) glds16(vsrc+(long)(t)*KVBLK*KP,(unsigned)__builtin_amdgcn_readfirstlane(vdst+(slot)))
  const int vb0=(int)(lds0+LDS_V)+((lane>>4)&1)*32+(lane&3)*8+(4*hi+((lane&15)>>2))*64;
  const char*Kbase=shm+LDS_K; bf16x8 kf[8];
  const lds_cptr shm3=(lds_cptr)shm; const lds_cptr kp0=shm3+LDS_K+hi*1024+r32*16; const lds_cptr vp0=shm3+LDS_V+((lane>>4)&1)*32+(lane&3)*8+(4*hi+((lane&15)>>2))*64;
  const int NT=S/KVBLK;
  DMA_K(0,0);DMA_V(0,0);DMA_K(1,SLOTB);
  bf16x8 qr[4];
  #pragma unroll
  for(int d0=0;d0<4;++d0)qr[d0]=*reinterpret_cast<const bf16x8*>(&Qw[(long)r32*QP+d0*16+hi*8]);
  float mhat=0.f,l_reg=0.f;f32x16 o[2];o[0]=f32x16{};o[1]=f32x16{};f32x16 negm=f32x16{}; if constexpr(SREF){ _Pragma("unroll") for(int r=0;r<16;++r)negm[r]=-mref; } asm volatile("":"+v"(negm));
  #define CMASK(P0,P1,t) do{}while(0)
  bool resc=false;
  #define START(P0,P1) do{ resc=false; \
    if constexpr(!SREF){ const float rm=rowmax(P0,P1); const float dl=rm; mhat=fadd_s(mhat,dl); \
      _Pragma("unroll") for(int r=0;r<16;++r){P0[r]=fsub_s(P0[r],dl);P1[r]=fsub_s(P1[r],dl);} \
      _Pragma("unroll") for(int r=0;r<16;++r)negm[r]=-mhat; asm volatile("":"+v"(negm)); } \
    _Pragma("unroll") for(int r=0;r<16;++r)P0[r]=__builtin_amdgcn_exp2f(P0[r]); }while(0)
  #define RESC() do{ if constexpr(!SREF) if(resc){ asm volatile("s_waitcnt lgkmcnt(0)":::"memory"); \
      _Pragma("unroll") for(int d_=0;d_<2;++d_) _Pragma("unroll") for(int r=0;r<16;++r)o[d_][r]*=wsf[crow(r,hi)]; } }while(0)
  f32x16 pA0,pA1,pB0,pB1;
  int sl_prev=0,sl_cur=0,sl_next=SLOTB;
  #define ROT() do{sl_prev=sl_cur;sl_cur=sl_next;sl_next=(sl_next==(NSLOT-1)*SLOTB)?0:sl_next+SLOTB;}while(0)
  DMA_K(2,2*SLOTB);
  WAIT_BAR(3);
  qkt(pA0,pA1,Kbase,qr,negm,r32,hi);asm volatile("s_nop 15\n\ts_nop 7":"+v"(pA0),"+v"(pA1));CMASK(pA0,pA1,0);
  START(pA0,pA1);
  _Pragma("unroll") for(int r=0;r<16;++r)pA1[r]=__builtin_amdgcn_exp2f(pA1[r]);
  WAIT_BAR(0);
  DMA_K(3,0);DMA_V(1,SLOTB);
  ROT();
  kload8(kf,kp0+sl_cur);
  WAIT_BAR(2);
  s16x4 vlo[8],vhi[8]; u32x4 pw0,pw1,pw2,pw3;
  #define PKW(P,B) cvtpk_s(P[B],P[B+1])
  #define PAF(k) __builtin_bit_cast(bf16x8,pw##k)
  #define VFR(i) (bf16x8){vlo[i][0],vlo[i][1],vlo[i][2],vlo[i][3],vhi[i][0],vhi[i][1],vhi[i][2],vhi[i][3]}
  #define PIN(x) asm volatile("":"+v"(x))
  #define MX3(a,b,c) __builtin_fmaxf(__builtin_fmaxf((a),(b)),(c))
  #define GAPA(MF,A0,A1,A2,A3,W0,W1,PW) do{ MF; sacc+=A0; sacc+=A1; sacc+=A2; sacc+=A3; PIN(sacc); W0; W1; PIN(PW); SBAR(); }while(0)
  #define EX(v) __builtin_amdgcn_exp2f(v)
  #define GAPB(MF,X,B) do{ MF; X[B]=EX(X[B]); X[B+1]=EX(X[B+1]); X[B+2]=EX(X[B+2]); X[B+3]=EX(X[B+3]); PIN(X); SBAR(); }while(0)
  #define VRD(i) do{ vlo[i]=vtr(vp_+(((i)>>2)*4096+((i)&3)*1024)); vhi[i]=vtr(vp_+(((i)>>2)*4096+((i)&3)*1024+512)); }while(0)
  #define KRD(G,j) do{ if(G){ kload2(kf,kp0+sl_next,j); SBAR(); } }while(0)
  #define STEP(C0,C1,P0,P1,t,GK,GV,GL) do{ SBAR(); \
    const lds_cptr vp_=vp0+sl_prev; \
    VRD(0); SBAR(); float sacc=(P0[0]+P0[1]); \
    GAPA(C0=__builtin_amdgcn_mfma_f32_32x32x16_bf16(kf[0],qr[0],negm,0,0,0), P0[2],P0[3],P0[4],P0[5],     pw0[0]=PKW(P0,0), pw0[1]=PKW(P0,2), pw0); \
    VRD(4); SBAR(); GAPA(C1=__builtin_amdgcn_mfma_f32_32x32x16_bf16(kf[1],qr[0],negm,0,0,0), P0[6],P0[7],P0[8],P0[9],     pw0[2]=PKW(P0,4), pw0[3]=PKW(P0,6), pw0); \
    VRD(1); SBAR(); GAPA(C0=__builtin_amdgcn_mfma_f32_32x32x16_bf16(kf[2],qr[1],C0,0,0,0),   P0[10],P0[11],P0[12],P0[13], pw1[0]=PKW(P0,8), pw1[1]=PKW(P0,10), pw1); \
    VRD(5); SBAR(); GAPA(C1=__builtin_amdgcn_mfma_f32_32x32x16_bf16(kf[3],qr[1],C1,0,0,0),   P0[14],P0[15],P1[0],P1[1],   pw1[2]=PKW(P0,12),pw1[3]=PKW(P0,14), pw1); \
    VRD(2); SBAR(); GAPA(C0=__builtin_amdgcn_mfma_f32_32x32x16_bf16(kf[4],qr[2],C0,0,0,0),   P1[2],P1[3],P1[4],P1[5],     pw2[0]=PKW(P1,0), pw2[1]=PKW(P1,2), pw2); \
    VRD(6); SBAR(); GAPA(C1=__builtin_amdgcn_mfma_f32_32x32x16_bf16(kf[5],qr[2],C1,0,0,0),   P1[6],P1[7],P1[8],P1[9],     pw2[2]=PKW(P1,4), pw2[3]=PKW(P1,6), pw2); \
    VRD(3); SBAR(); GAPA(C0=__builtin_amdgcn_mfma_f32_32x32x16_bf16(kf[6],qr[3],C0,0,0,0),   P1[10],P1[11],P1[12],P1[13], pw3[0]=PKW(P1,8), pw3[1]=PKW(P1,10), pw3); \
    VRD(7); SBAR(); GAPA(C1=__builtin_amdgcn_mfma_f32_32x32x16_bf16(kf[7],qr[3],C1,0,0,0),   P1[14],P1[15],0.f,0.f,       pw3[2]=PKW(P1,12),pw3[3]=PKW(P1,14), pw3); \
    l_reg+=sacc; \
    if(GK){DMA_K((t)+3,sl_cur);} if(GV){DMA_V((t)+1,sl_next);} \
    CMASK(C0,C1,t); \
    if constexpr(!SREF){ float a=MX3(C0[0],C0[1],C1[0]),b=MX3(C0[2],C0[3],C1[1]); a=MX3(a,C1[2],C1[3]); \
      _Pragma("unroll") for(int r=4;r<16;r+=4){a=MX3(a,C0[r],C0[r+1]);b=MX3(b,C0[r+2],C0[r+3]);a=MX3(a,C1[r],C1[r+1]);b=MX3(b,C1[r+2],C1[r+3]);} \
      float rm=__builtin_fmaxf(a,b); { auto rr=__builtin_amdgcn_permlane32_swap(__float_as_uint(rm),__float_as_uint(rm),false,false); rm=__builtin_fmaxf(__uint_as_float(rr[0]),__uint_as_float(rr[1])); } \
      resc=false; \
      if(__builtin_expect(__any(rm>(float)THRL),0)){ const float dl=__builtin_fmaxf(rm,0.f); mhat+=dl; \
        _Pragma("unroll") for(int r=0;r<16;++r){C0[r]-=dl;C1[r]-=dl;} \
        _Pragma("unroll") for(int r=0;r<16;++r)negm[r]=-mhat; asm volatile("":"+v"(negm)); \
        const float f=__builtin_amdgcn_exp2f(-dl); l_reg*=f; if(hi==0)wsf[r32]=f; resc=true; } } \
    SBAR(); \
    GAPB(o[0]=__builtin_amdgcn_mfma_f32_32x32x16_bf16(PAF(0),VFR(0),o[0],0,0,0), C0,0); \
    GAPB(o[1]=__builtin_amdgcn_mfma_f32_32x32x16_bf16(PAF(0),VFR(4),o[1],0,0,0), C0,4); \
    KRD(GL,0); GAPB(o[0]=__builtin_amdgcn_mfma_f32_32x32x16_bf16(PAF(1),VFR(1),o[0],0,0,0), C0,8); \
    KRD(GL,1); GAPB(o[1]=__builtin_amdgcn_mfma_f32_32x32x16_bf16(PAF(1),VFR(5),o[1],0,0,0), C0,12); \
    KRD(GL,2); GAPB(o[0]=__builtin_amdgcn_mfma_f32_32x32x16_bf16(PAF(2),VFR(2),o[0],0,0,0), C1,0); \
    KRD(GL,3); GAPB(o[1]=__builtin_amdgcn_mfma_f32_32x32x16_bf16(PAF(2),VFR(6),o[1],0,0,0), C1,4); \
    GAPB(o[0]=__builtin_amdgcn_mfma_f32_32x32x16_bf16(PAF(3),VFR(3),o[0],0,0,0), C1,8); \
    GAPB(o[1]=__builtin_amdgcn_mfma_f32_32x32x16_bf16(PAF(3),VFR(7),o[1],0,0,0), C1,12); \
    }while(0)
  int t=1;
  #undef CMASK
  #define CMASK(P0,P1,t) do{}while(0)
  for(;t+5<NT;t+=2){
    STEP(pB0,pB1,pA0,pA1,t,true,true,true);     WAIT_BAR(2); RESC(); ROT();
    STEP(pA0,pA1,pB0,pB1,t+1,true,true,true);   WAIT_BAR(2); RESC(); ROT();
  }
  #undef CMASK
  #define CMASK(P0,P1,t) do{}while(0)
  #define ENDW(tt) do{ if((tt)+3<NT){WAIT_BAR(2);} else if((tt)+2<NT){WAIT_BAR(1);} else {WAIT_BAR(0);} }while(0)
  for(;t+1<NT;t+=2){
    STEP(pB0,pB1,pA0,pA1,t,(t+3<NT),(t+1<NT),(t+1<NT));       ENDW(t);   RESC(); ROT();
    STEP(pA0,pA1,pB0,pB1,t+1,(t+4<NT),(t+2<NT),(t+2<NT));     ENDW(t+1); RESC(); ROT();
  }
  STEP(pB0,pB1,pA0,pA1,NT-1,false,false,false); RESC();
  { float sacc=pB0[0]+pB0[1]; _Pragma("unroll") for(int r=2;r<16;++r)sacc+=pB0[r]; _Pragma("unroll") for(int r=0;r<16;++r)sacc+=pB1[r]; l_reg+=sacc;
    pw0=(u32x4){PKW(pB0,0),PKW(pB0,2),PKW(pB0,4),PKW(pB0,6)};pw1=(u32x4){PKW(pB0,8),PKW(pB0,10),PKW(pB0,12),PKW(pB0,14)};pw2=(u32x4){PKW(pB1,0),PKW(pB1,2),PKW(pB1,4),PKW(pB1,6)};pw3=(u32x4){PKW(pB1,8),PKW(pB1,10),PKW(pB1,12),PKW(pB1,14)};
    SBAR(); pv(o,vb0+sl_cur,PAF(0),PAF(1),PAF(2),PAF(3)); }
  #undef PKW
  #undef PAF
  #undef VFR
  #undef PIN
  #undef MX3
  #undef GAPA
  #undef GAPB
  #undef EX
  #undef VRD
  #undef KRD
  #undef STEP
  #undef ENDW
  {auto rr=__builtin_amdgcn_permlane32_swap(__float_as_uint(l_reg),__float_as_uint(l_reg),false,false);l_reg=__uint_as_float(rr[0])+__uint_as_float(rr[1]);}
  if(hi==0)wsf[32+r32]=l_reg;asm volatile("s_waitcnt lgkmcnt(0)":::"memory");
  float rli[16];
  #pragma unroll
  for(int r=0;r<16;++r)rli[r]=__builtin_amdgcn_rcpf(wsf[32+crow(r,hi)]);
  bf16*Ow=O+(rowbase+q0+wid*QBLK)*OP+h*D;
  { bf16*stg=(bf16*)(shm+LDS_OST)+wid*2048;
    #pragma unroll
    for(int r=0;r<16;++r){const int orow=crow(r,hi);
      #pragma unroll
      for(int d0=0;d0<2;++d0)stg[orow*64+d0*32+r32]=__float2bfloat16(o[d0][r]*rli[r]);}
    asm volatile("s_waitcnt lgkmcnt(0)":::"memory");
    #pragma unroll
    for(int i=0;i<4;++i){const int row=i*8+(lane>>3),ch=lane&7; const u32x4 v=*(const u32x4*)(stg+row*64+ch*8); ATTN_STORE16(Ow+(long)row*OP+ch*8,v);} }
  asm volatile("s_waitcnt lgkmcnt(0)\n\ts_barrier":::"memory");
  #undef DMA_K
  #undef DMA_V
  #undef CMASK
  #undef START
  #undef RESC
  #undef ROT
}
constexpr int ATTN_LDS_BYTES=LDS_BYTES;
#undef SBAR
#undef WAIT_BAR
}
constexpr int DMODEL = 1024, NTOK = 131072, NTP = 65536, DFF = 2816, NPROJ = 2304, NBATCH = 24, NLAYER = 2, NMOD = 6144;
constexpr int NWAVES = 8, NTHREADS = 512;
constexpr int LDS_TOTAL = 147456;
constexpr float RMS_EPS = 1e-6f;
constexpr size_t MiB = 1u << 20;
constexpr size_t WS_BAR = 1u << 20, WS_BAR_BYTES = 65536;
constexpr size_t WS_ROT = 0;
constexpr size_t WS_MOD = 2 * MiB;
constexpr size_t WS_W = 4 * MiB;
constexpr size_t W_IN = 0, W_OUT = W_IN + (size_t)NPROJ * 1024 * 2, W_GU = W_OUT + (size_t)1024 * 1024 * 2, W_DN = W_GU + (size_t)2 * DFF * 1024 * 2, W_LAYER = W_DN + (size_t)1024 * DFF * 2;
static_assert(WS_W + 2 * W_LAYER <= 52 * MiB, "weights");
constexpr size_t WS_H = 52 * MiB;
constexpr size_t WS_F = 308 * MiB;
constexpr size_t WS_Q = WS_F, WS_K = WS_Q + 128 * MiB, WS_V = WS_K + 32 * MiB, WS_BG = WS_V + 32 * MiB, WS_CU = WS_BG + 128 * MiB, WS_MODP = WS_CU + 128 * MiB;
constexpr int MOD_KC = 32;
constexpr size_t WS_END = WS_F + (size_t)NTOK * DFF * 2;
static_assert(WS_ROT == pg8::PWS_ROT && WS_Q == pg8::PWS_Q && WS_K == pg8::PWS_K && WS_V == pg8::PWS_V && WS_BG == pg8::PWS_BG && WS_CU == pg8::PWS_CU, "EpiProj offsets");
static_assert(WS_MODP + (size_t)MOD_KC * NLAYER * NBATCH * NMOD * 4 <= WS_END && WS_END <= 1024 * MiB, "d_ws map");

#define LAS __attribute__((address_space(3)))
typedef unsigned short bf16;
typedef unsigned v4u __attribute__((ext_vector_type(4)));
typedef unsigned v2u __attribute__((ext_vector_type(2)));
typedef float f32x4 __attribute__((ext_vector_type(4)));
__device__ __forceinline__ unsigned pk2(float lo, float hi) { return pg8::cvt_pk_bf16(lo, hi); }
__device__ __forceinline__ float wave_sum(float v) {
#pragma unroll
    for (int o = 1; o < 64; o <<= 1) v += __shfl_xor(v, o);
    return v;
}
__device__ __forceinline__ int batch_of_row(int row) { return row < NTP ? (row >> 13) : 8 + ((row - NTP) >> 12); }
__device__ __forceinline__ int team_tile(int m, int x) { return m < 32 ? 32 * x + m : 256 + 32 * x + (m - 32); }

struct Args {
    const float *xp, *xs, *cp, *cs, *w_mod, *b_mod, *g_mix, *w_in, *q_gain, *k_gain, *conv_w, *w_out, *g_ffn, *w_gate, *w_up, *w_down, *g_final;
    float* out; unsigned char* ws; int G; int pad;
};

__device__ __forceinline__ void transpose_item(const float* W, int K, int N, bf16* WT, int k0, int n0, int dst_row0, LAS float* scr, int lane) {
    float wv[32];
#pragma unroll
    for (int i = 0; i < 32; ++i) wv[i] = __builtin_nontemporal_load(W + (size_t)(k0 + 2 * i + (lane >> 5)) * N + n0 + (lane & 31));
#pragma unroll
    for (int i = 0; i < 32; ++i) scr[(2 * i + (lane >> 5)) * 33 + (lane & 31)] = wv[i];
    asm volatile("s_waitcnt lgkmcnt(0)" ::: "memory");
    const int c = lane & 7;
#pragma unroll
    for (int j = 0; j < 4; ++j) { const int n = (lane >> 3) + 8 * j; const LAS float* s = scr + (8 * c) * 33 + n;
        v4u o; o.x = pk2(s[0 * 33], s[1 * 33]); o.y = pk2(s[2 * 33], s[3 * 33]); o.z = pk2(s[4 * 33], s[5 * 33]); o.w = pk2(s[6 * 33], s[7 * 33]);
        *(v4u*)(WT + (size_t)(dst_row0 + n) * K + k0 + 8 * c) = o; }
    asm volatile("s_waitcnt lgkmcnt(0)" ::: "memory");
}
__device__ __forceinline__ int proj_row(int L) {
    if (L < 1280) { const int grp = L >> 6, d = L & 63; return 256 * (grp >> 2) + 128 * (d >> 5) + 32 * (grp & 3) + (d & 31); }
    if (L < 1792) { const int ch = L - 1280; return 256 * (5 + (ch >> 7)) + (ch & 127); }
    const int ch = L - 1792; return 256 * (5 + (ch >> 7)) + 128 + (ch & 127);
}

__device__ __forceinline__ void phase_prologue(const __attribute__((address_space(4))) Args& a, LAS unsigned char* lds, int gw, int NGW, int wave, int lane) {
    unsigned char* ws = a.ws;
    {
        LAS float* scr = (LAS float*)(lds + wave * 16384);
        constexpr int I_IN = 16 * (NPROJ / 32), I_OUT = 16 * 32, I_G = 16 * (DFF / 32), I_D = (DFF / 64) * 32, I_LAYER = I_IN + I_OUT + 2 * I_G + I_D;
        for (int it = gw; it < NLAYER * I_LAYER; it += NGW) {
            const int l = it / I_LAYER; int r = it % I_LAYER; unsigned char* wl = ws + WS_W + l * W_LAYER;
            if (r < I_IN) { const int nb = NPROJ / 32, k0 = 64 * (r / nb), n0 = 32 * (r % nb); transpose_item(a.w_in + (size_t)l * 1024 * NPROJ, 1024, NPROJ, (bf16*)(wl + W_IN), k0, n0, proj_row(n0), scr, lane); continue; } r -= I_IN;
            if (r < I_OUT) { const int k0 = 64 * (r / 32), n0 = 32 * (r % 32); transpose_item(a.w_out + (size_t)l * 1024 * 1024, 1024, 1024, (bf16*)(wl + W_OUT), k0, n0, n0, scr, lane); continue; } r -= I_OUT;
            if (r < I_G) { const int nb = DFF / 32, k0 = 64 * (r / nb), n0 = 32 * (r % nb); transpose_item(a.w_gate + (size_t)l * 1024 * DFF, 1024, DFF, (bf16*)(wl + W_GU), k0, n0, 256 * (n0 >> 7) + (n0 & 127), scr, lane); continue; } r -= I_G;
            if (r < I_G) { const int nb = DFF / 32, k0 = 64 * (r / nb), n0 = 32 * (r % nb); transpose_item(a.w_up + (size_t)l * 1024 * DFF, 1024, DFF, (bf16*)(wl + W_GU), k0, n0, 256 * (n0 >> 7) + 128 + (n0 & 127), scr, lane); continue; } r -= I_G;
            { const int k0 = 64 * (r / 32), n0 = 32 * (r % 32); transpose_item(a.w_down + (size_t)l * DFF * 1024, DFF, 1024, (bf16*)(wl + W_DN), k0, n0, n0, scr, lane); }
        }
    }
    if (blockIdx.x == 0) {
        float* rot = (float*)(ws + WS_ROT);
        for (int i = threadIdx.x; i < 128 * 16; i += NTHREADS) { const int pos = i >> 4, j = i & 15; const float inv = powf(10000.0f, -(float)j / 16.0f); const float ang = (float)pos * inv;
            rot[2 * i] = cosf(ang); rot[2 * i + 1] = sinf(ang); }
    }
    __syncthreads();
    {
        LAS float* sc = (LAS float*)lds;
        for (int i = threadIdx.x; i < NBATCH * 1024; i += NTHREADS) { const float v = i < 8 * 1024 ? a.cp[i] : a.cs[i - 8 * 1024]; sc[i] = v / (1.0f + __expf(-v)); }
        __syncthreads();
        float* modp = (float*)(ws + WS_MODP);
        constexpr int NCG = NMOD / 64, ITEMS = NLAYER * NCG * MOD_KC;
        for (int it = gw; it < ITEMS; it += NGW) {
            const int kc = it % MOD_KC, cgp = (it / MOD_KC) % NCG, l = it / (MOD_KC * NCG);
            const float* wp = a.w_mod + (size_t)l * 1024 * NMOD + (size_t)(kc * 32) * NMOD + cgp * 64 + lane;
            float accb[NBATCH];
#pragma unroll
            for (int b = 0; b < NBATCH; ++b) accb[b] = 0.f;
            float wall[32];
#pragma unroll
            for (int j = 0; j < 32; ++j) wall[j] = __builtin_nontemporal_load(wp + (size_t)j * NMOD);
#pragma unroll
            for (int k4 = 0; k4 < 8; ++k4) {
                float w[4];
#pragma unroll
                for (int j = 0; j < 4; ++j) w[j] = wall[k4 * 4 + j];
#pragma unroll
                for (int b = 0; b < NBATCH; ++b) { const f32x4 s = *(const LAS f32x4*)(sc + b * 1024 + kc * 32 + k4 * 4); accb[b] += (w[0] * s[0] + w[1] * s[1]) + (w[2] * s[2] + w[3] * s[3]); }
            }
            float* o = modp + ((size_t)(kc * NLAYER + l) * NBATCH) * NMOD + cgp * 64 + lane;
#pragma unroll
            for (int b = 0; b < NBATCH; ++b) o[(size_t)b * NMOD] = accb[b];
        }
    }
}
__device__ __forceinline__ void phase_mod_final(const __attribute__((address_space(4))) Args& a) {
    const float* modp = (const float*)(a.ws + WS_MODP); float* mod = (float*)(a.ws + WS_MOD);
    for (int i = blockIdx.x * NTHREADS + threadIdx.x; i < NLAYER * NBATCH * NMOD; i += gridDim.x * NTHREADS) {
        const int n = i % NMOD, l = i / (NBATCH * NMOD); float s = a.b_mod[l * NMOD + n];
#pragma unroll 8
        for (int kc = 0; kc < MOD_KC; ++kc) s += modp[(size_t)kc * NLAYER * NBATCH * NMOD + i];
        mod[i] = s;
    }
}
__device__ __forceinline__ void wave_sum4(float (&s)[4]) {
#pragma unroll
    for (int o = 1; o < 64; o <<= 1) {
#pragma unroll
        for (int i = 0; i < 4; ++i) s[i] += __shfl_xor(s[i], o); }
}
__device__ __forceinline__ void unpack8v(const v4u p, f32x4& a, f32x4& b) {
    a = (f32x4){__uint_as_float(p.x << 16), __uint_as_float(p.x & 0xffff0000u), __uint_as_float(p.y << 16), __uint_as_float(p.y & 0xffff0000u)};
    b = (f32x4){__uint_as_float(p.z << 16), __uint_as_float(p.z & 0xffff0000u), __uint_as_float(p.w << 16), __uint_as_float(p.w & 0xffff0000u)};
}
template <bool IN_BF16>
__device__ __forceinline__ void phase_norm(const float* xa, const float* xb, const bf16* res, const float* g, const float* shift, const float* scale, bf16* H, int x, int wv, int nwv, int lane, int rev) {
    for (int ch0 = wv; ch0 < 1024; ch0 += nwv) {
        const int ch = rev ? 1023 - ch0 : ch0; const int r0 = team_tile(ch >> 4, x) * 256 + (ch & 15) * 16; const int b = batch_of_row(r0); const float* xin = r0 < NTP ? xa : xb;
        f32x4 gs[4], sh[4];
#pragma unroll
        for (int j = 0; j < 4; ++j) { const int c = 8 * lane + 512 * (j >> 1) + 4 * (j & 1); gs[j] = *(const f32x4*)(g + c) * (1.0f + *(const f32x4*)(scale + (size_t)b * NMOD + c)); sh[j] = *(const f32x4*)(shift + (size_t)b * NMOD + c); }
#pragma unroll 1
        for (int r = r0; r < r0 + 16; r += 4) {
            f32x4 v[4][4]; float s[4];
            if constexpr (IN_BF16) {
                v4u p[4][2];
#pragma unroll
                for (int i = 0; i < 4; ++i) { const v4u* xr = (const v4u*)(res + (size_t)(r + i) * 2048) + lane; p[i][0] = xr[0]; p[i][1] = xr[64]; }
#pragma unroll
                for (int i = 0; i < 4; ++i) { unpack8v(p[i][0], v[i][0], v[i][1]); unpack8v(p[i][1], v[i][2], v[i][3]); }
            } else {
#pragma unroll
                for (int i = 0; i < 4; ++i) { const f32x4* xr = (const f32x4*)(xin + (size_t)(r + i) * 1024) + 2 * lane;
                    v[i][0] = __builtin_nontemporal_load(xr); v[i][1] = __builtin_nontemporal_load(xr + 1); v[i][2] = __builtin_nontemporal_load(xr + 128); v[i][3] = __builtin_nontemporal_load(xr + 129); }
            }
#pragma unroll
            for (int i = 0; i < 4; ++i) { s[i] = 0.f;
#pragma unroll
                for (int j = 0; j < 4; ++j) s[i] += (v[i][j][0] * v[i][j][0] + v[i][j][1] * v[i][j][1]) + (v[i][j][2] * v[i][j][2] + v[i][j][3] * v[i][j][3]); }
            wave_sum4(s);
#pragma unroll
            for (int i = 0; i < 4; ++i) { const float rstd = 1.0f / sqrtf(s[i] * (1.0f / 1024.0f) + RMS_EPS);
                v4u* o = (v4u*)(H + (size_t)(r + i) * 1024) + lane;
#pragma unroll
                for (int h = 0; h < 2; ++h) { const f32x4 y0 = v[i][2 * h] * rstd * gs[2 * h] + sh[2 * h], y1 = v[i][2 * h + 1] * rstd * gs[2 * h + 1] + sh[2 * h + 1];
                    v4u w; w.x = pk2(y0[0], y0[1]); w.y = pk2(y0[2], y0[3]); w.z = pk2(y1[0], y1[1]); w.w = pk2(y1[2], y1[3]); o[64 * h] = w; } }
        }
    }
}
__device__ __forceinline__ void phase_final_norm(float* x, const float* g, int tx, int wv, int nwv, int lane) {
    f32x4 gs[4];
#pragma unroll
    for (int j = 0; j < 4; ++j) gs[j] = *(const f32x4*)(g + 8 * lane + 512 * (j >> 1) + 4 * (j & 1));
    for (int st = wv; st < 4096; st += nwv) {
        const int r = team_tile(st >> 6, tx) * 256 + (st & 63) * 4;
        f32x4 v[4][4]; float s[4]; v4u p[4][2];
#pragma unroll
        for (int i = 0; i < 4; ++i) { const v4u* xr = (const v4u*)(x + (size_t)(r + i) * 1024) + lane; p[i][0] = xr[0]; p[i][1] = xr[64]; }
#pragma unroll
        for (int i = 0; i < 4; ++i) { unpack8v(p[i][0], v[i][0], v[i][1]); unpack8v(p[i][1], v[i][2], v[i][3]); }
#pragma unroll
        for (int i = 0; i < 4; ++i) { s[i] = 0.f;
#pragma unroll
            for (int j = 0; j < 4; ++j) s[i] += (v[i][j][0] * v[i][j][0] + v[i][j][1] * v[i][j][1]) + (v[i][j][2] * v[i][j][2] + v[i][j][3] * v[i][j][3]); }
        wave_sum4(s);
#pragma unroll
        for (int i = 0; i < 4; ++i) { const float rstd = 1.0f / sqrtf(s[i] * (1.0f / 1024.0f) + RMS_EPS);
            f32x4* xr = (f32x4*)(x + (size_t)(r + i) * 1024) + 2 * lane;
            __builtin_nontemporal_store(v[i][0] * rstd * gs[0], xr); __builtin_nontemporal_store(v[i][1] * rstd * gs[1], xr + 1);
            __builtin_nontemporal_store(v[i][2] * rstd * gs[2], xr + 128); __builtin_nontemporal_store(v[i][3] * rstd * gs[3], xr + 129); }
    }
}
__device__ __forceinline__ void unpack8(const v4u p, float (&f)[8]) {
#pragma unroll
    for (int i = 0; i < 4; ++i) { f[2 * i] = __uint_as_float(p[i] << 16); f[2 * i + 1] = __uint_as_float(p[i] & 0xffff0000u); }
}
__device__ __forceinline__ void phase_conv(const bf16* Bg, const bf16* CU, const float* cw, bf16* MIX, int x, int wv, int nwv, int lane, int rev) {
    float w0[8], w1[8], w2[8];
#pragma unroll
    for (int i = 0; i < 8; ++i) { w0[i] = cw[8 * lane + i]; w1[i] = cw[512 + 8 * lane + i]; w2[i] = cw[1024 + 8 * lane + i]; }
    const v4u zero = {0u, 0u, 0u, 0u};
    for (int ch0 = wv; ch0 < 2048; ch0 += nwv) {
        const int ch = rev ? 2047 - ch0 : ch0; const int r0 = team_tile(ch >> 5, x) * 256 + (ch & 31) * 8; const int S = r0 < NTP ? 8192 : 4096;
        const v4u* cup = (const v4u*)(CU + (size_t)r0 * 512) + lane;
        const v4u* bgp = (const v4u*)(Bg + (size_t)r0 * 512) + lane;
        v4u cu[10], bg[8];
        cu[0] = ((r0 & (S - 1)) == 0) ? zero : cup[-64];
#pragma unroll
        for (int i = 0; i < 8; ++i) cu[i + 1] = cup[i * 64];
        cu[9] = (((r0 + 8) & (S - 1)) == 0) ? zero : cup[8 * 64];
#pragma unroll
        for (int i = 0; i < 8; ++i) bg[i] = bgp[i * 64];
#pragma unroll
        for (int i = 0; i < 8; ++i) {
            float p[8], c[8], n[8], g[8], o[8]; unpack8(cu[i], p); unpack8(cu[i + 1], c); unpack8(cu[i + 2], n); unpack8(bg[i], g);
#pragma unroll
            for (int k = 0; k < 8; ++k) o[k] = g[k] * (w0[k] * p[k] + w1[k] * c[k] + w2[k] * n[k]);
            v4u w; w.x = pk2(o[0], o[1]); w.y = pk2(o[2], o[3]); w.z = pk2(o[4], o[5]); w.w = pk2(o[6], o[7]);
            *((v4u*)(MIX + (size_t)(r0 + i) * 1024 + 512) + lane) = w;
        }
    }
}
template <bool SREF>
__device__ __forceinline__ void attn_units(float mref, const bf16* Q, const bf16* K, const bf16* V, bf16* MIX, char* lds, int x, int r, int n, int rev) {
    for (int u0 = r; u0 < 512; u0 += n) { const int u = rev ? 511 - u0 : u0;
        long rowbase; int S, h, qb;
        if (u < 256) { rowbase = (long)x * 8192; S = 8192; h = u >> 5; qb = u & 31; }
        else { const int u2 = u - 256, w = u2 & 127; rowbase = NTP + (long)(2 * x + (u2 >> 7)) * 4096; S = 4096; h = w >> 4; qb = w & 15; }
        attn_body::attn_unit<8, SREF>(mref, rowbase, S, h, h >> 2, qb, (const attn_body::bf16*)Q, (const attn_body::bf16*)K, (const attn_body::bf16*)V, (attn_body::bf16*)MIX, lds);
    }
}
__device__ __forceinline__ void phase_attn(const float* qg, const float* kg, const bf16* Q, const bf16* K, const bf16* V, bf16* MIX, char* lds, int x, int r, int n, int lane, int rev) {
    float qm = fabsf(qg[lane]), km = fabsf(kg[lane]);
#pragma unroll
    for (int o = 1; o < 64; o <<= 1) { qm = fmaxf(qm, __shfl_xor(qm, o)); km = fmaxf(km, __shfl_xor(km, o)); }
    const float mref = __builtin_bit_cast(float, __builtin_amdgcn_readfirstlane(__builtin_bit_cast(int, 8.0f * 1.4426950408889634f * 1.02f * qm * km + 0.25f)));
    if (mref <= 40.0f) attn_units<true>(mref, Q, K, V, MIX, lds, x, r, n, rev);
    else attn_units<false>(0.f, Q, K, V, MIX, lds, x, r, n, rev);
}

#define XB_TMO      128
#define XB_XCNT(j)  (256  + 64 * (j))
#define XB_XSUB(j)  (1280 + 64 * (j))
#define XB_XGEN(j)  (2304 + 64 * (j))
#define XB_TOP      3328
#define XB_TOPGEN   3392
#define XCD_BAR_WORDS 3456
#define XB_SPIN_CAP (1u << 18)

__device__ __forceinline__ unsigned xb_ld(unsigned* p)              { return __hip_atomic_load(p, __ATOMIC_RELAXED, __HIP_MEMORY_SCOPE_AGENT); }
__device__ __forceinline__ unsigned xb_add(unsigned* p, unsigned v) { return __hip_atomic_fetch_add(p, v, __ATOMIC_RELAXED, __HIP_MEMORY_SCOPE_AGENT); }
__device__ __forceinline__ unsigned xb_xcc_id() { return (unsigned)__builtin_amdgcn_s_getreg((3 << 11) | 20) & 0xFu; }
#define XB_SPIN(cond, bar) do { unsigned _sp = 0; while (cond) { __builtin_amdgcn_s_sleep(1); \
    if ((++_sp & 255u) == 0u) { if (xb_ld(&(bar)[XB_TMO])) break; if (_sp > XB_SPIN_CAP) { atomicAdd(&(bar)[XB_TMO], 1u); break; } } } } while (0)

struct XcdBarrier {
    unsigned* bar; unsigned x;
    volatile LAS unsigned* st;
};

__device__ __forceinline__ XcdBarrier xcd_barrier_post(unsigned* bar, volatile LAS unsigned* st) {
    XcdBarrier b; b.bar = bar; b.x = xb_xcc_id(); b.st = st;
    if (threadIdx.x == 0) (void)xb_add(&bar[XB_XCNT(b.x)], 1u);
    return b;
}
__device__ __forceinline__ void xcd_barrier_complete(unsigned* bar, unsigned x, unsigned& nloc, unsigned& nx) {
    const unsigned G = gridDim.x * gridDim.y * gridDim.z;
    unsigned sum, cnt, mine, sp = 0u;
    for (;;) {
        sum = 0u; cnt = 0u; mine = 0u;
#pragma unroll
        for (unsigned j = 0; j < 16; ++j) { const unsigned c = xb_ld(&bar[XB_XCNT(j)]); sum += c; cnt += (c > 0u) ? 1u : 0u; mine = (j == x) ? c : mine; }
        if (sum == G) break;
        __builtin_amdgcn_s_sleep(1);
        if ((++sp & 255u) == 0u) { if (xb_ld(&bar[XB_TMO])) break; if (sp > XB_SPIN_CAP) { atomicAdd(&bar[XB_TMO], 1u); break; } }
    }
    nloc = mine > 0u ? mine : 1u; nx = cnt > 0u ? cnt : 1u;
}

__device__ __forceinline__ void xcd_barrier(const XcdBarrier& b) {
    asm volatile("s_waitcnt vmcnt(0)" ::: "memory");
    __syncthreads();
    if (threadIdx.x == 0) {
        unsigned* bar = b.bar;
        __builtin_amdgcn_s_waitcnt(0);
        unsigned nloc = b.st[0], nx = b.st[1];
        if (nloc == 0u) { xcd_barrier_complete(bar, b.x, nloc, nx); b.st[0] = nloc; b.st[1] = nx; }
        const unsigned old = xb_add(&bar[XB_XSUB(b.x)], 1u);
        const unsigned gen = old / nloc;
        if (old + 1u == (gen + 1u) * nloc) {
            __builtin_amdgcn_fence(__ATOMIC_RELEASE, "agent");
            asm volatile("s_waitcnt vmcnt(0)" ::: "memory");
            const unsigned og = xb_add(&bar[XB_TOP], 1u);
            const unsigned tg = og / nx;
            if (og + 1u == (tg + 1u) * nx) xb_add(&bar[XB_TOPGEN], 1u);
            else XB_SPIN(xb_ld(&bar[XB_TOPGEN]) == tg, bar);
            __builtin_amdgcn_fence(__ATOMIC_ACQUIRE, "agent");
            xb_add(&bar[XB_XGEN(b.x)], 1u);
            asm volatile("s_waitcnt vmcnt(0)" ::: "memory");
        } else {
            XB_SPIN(xb_ld(&bar[XB_XGEN(b.x)]) == gen, bar);
            __builtin_amdgcn_fence(__ATOMIC_ACQUIRE, "agent");
            asm volatile("s_waitcnt vmcnt(0)" ::: "memory");
        }
    }
    __syncthreads();
}


typedef __attribute__((address_space(4))) const Args* KArgs;
__device__ __forceinline__ KArgs kargs() { KArgs p = (KArgs)__builtin_amdgcn_kernarg_segment_ptr(); asm volatile("" : "+s"(p)); return p; }
struct TeamOrder {
    int nN, x, r, n, rev;
    __device__ __forceinline__ bool next(int i, pg8::Unit& u) const {
        const int L = i * n + r; if (L >= 64 * nN) return false;
        const int nig = 8 * nN, gid = L / nig, w = L % nig; int m = gid * 8 + (w & 7); if (rev) m = 63 - m;
        u.pm = team_tile(m, x); u.pn = w >> 3; return true;
    }
    __device__ __forceinline__ void a_ready(const pg8::Unit&) const {}
    __device__ __forceinline__ void done(const pg8::Unit&) const {}
};
#define TB_WORD(x) (4096 + 128 * (x))
#define ID_WORD(b) (8192 + (b))
__device__ __forceinline__ void team_barrier(unsigned* bar, int x, unsigned n) {
    asm volatile("s_waitcnt vmcnt(0)" ::: "memory");
    __syncthreads();
    if (threadIdx.x == 0) {
        __builtin_amdgcn_s_waitcnt(0);
        unsigned* tb = bar + TB_WORD(x);
        const unsigned old = xb_add(&tb[0], 1u), gen = old / n;
        if (old + 1u == (gen + 1u) * n) xb_add(&tb[64], 1u);
        else XB_SPIN(xb_ld(&tb[64]) == gen, bar);
        __builtin_amdgcn_fence(__ATOMIC_ACQUIRE, "agent");
        asm volatile("s_waitcnt vmcnt(0)" ::: "memory");
    }
    __syncthreads();
}
#ifndef PH
#define PH 0xffff
#endif
#ifndef DBL
#define DBL 0
#endif
#define REP(bit) _Pragma("unroll 1") for (int rep_ = 0; rep_ < (((DBL) & (bit)) ? 2 : 1); ++rep_)
__global__ void __launch_bounds__(NTHREADS, 2) fwd_megakernel(Args a_unused) {
    extern __shared__ __attribute__((aligned(16))) unsigned char lds_raw[];
    cg::grid_group grid = cg::this_grid();
    volatile LAS unsigned* const bst = (volatile LAS unsigned*)((LAS unsigned char*)lds_raw + 131072 + 64);
    if (threadIdx.x < 3) bst[threadIdx.x] = 0u;
    __syncthreads();
    (void)xcd_barrier_post((unsigned*)(kargs()->ws + WS_BAR), bst);
    if (threadIdx.x == 0) ((unsigned*)(kargs()->ws + WS_BAR))[ID_WORD(blockIdx.x)] = 1u + xb_xcc_id();
#define GSYNC() do { XcdBarrier xb_; xb_.bar = (unsigned*)(kargs()->ws + WS_BAR); xb_.x = xb_xcc_id(); xb_.st = (volatile LAS unsigned*)((LAS unsigned char*)lds_raw + 131072 + 64); xcd_barrier(xb_); } while (0)
#define TEAM_OK() (((volatile LAS unsigned*)((LAS unsigned char*)lds_raw + 131072 + 64))[2] != 0u)
#define TSYNC() do { if (TEAM_OK()) team_barrier((unsigned*)(kargs()->ws + WS_BAR), (int)(blockIdx.x & 7), gridDim.x >> 3); else GSYNC(); } while (0)
#define LDSP ((LAS unsigned char*)lds_raw)
#define FRAME() const KArgs A = kargs(); int tid_l = threadIdx.x; asm volatile("" : "+v"(tid_l)); const int lane = tid_l & 63, wave = __builtin_amdgcn_readfirstlane(tid_l >> 6); const int G = gridDim.x, bx = blockIdx.x; \
    const int vcu = (G % 8 == 0) ? (bx % 8) * (G / 8) + bx / 8 : bx; const int gw = vcu * NWAVES + wave, NGW = G * NWAVES; unsigned char* const ws = A->ws; const int tx = bx & 7, tr = bx >> 3, tn = G >> 3, wv = tr * NWAVES + wave, nwv = tn * NWAVES; (void)lane; (void)gw; (void)NGW; (void)ws; (void)vcu; (void)tx; (void)tr; (void)tn; (void)wv; (void)nwv
#define LAYER() const float* const modl = (const float*)(ws + WS_MOD) + (size_t)l * NBATCH * NMOD; unsigned char* const wl = ws + WS_W + l * W_LAYER; (void)modl; (void)wl
#if PH & 1
    REP(1)
    { FRAME(); phase_prologue(*A, LDSP, gw, NGW, wave, lane); __syncthreads(); }
#endif
    grid.sync();
    {
        const unsigned* ids = (const unsigned*)(kargs()->ws + WS_BAR) + ID_WORD(0); const int G_ = gridDim.x; int ok = (G_ % 8 == 0) && (G_ <= NTHREADS);
        if ((int)threadIdx.x < G_ && ok) ok = __hip_atomic_load(ids + threadIdx.x, __ATOMIC_RELAXED, __HIP_MEMORY_SCOPE_AGENT) == __hip_atomic_load(ids + (threadIdx.x & 7), __ATOMIC_RELAXED, __HIP_MEMORY_SCOPE_AGENT);
        ok = __syncthreads_and(ok);
        if (threadIdx.x == 0) ((volatile LAS unsigned*)((LAS unsigned char*)lds_raw + 131072 + 64))[2] = ok ? 1u : 0u;
        __syncthreads();
    }
#if PH & 2
    { FRAME(); phase_mod_final(*A); }
#endif
    GSYNC();
#pragma unroll 1
    for (int l = 0; l < NLAYER; ++l) {
#if PH & 4
        REP(4)
        { FRAME(); LAYER();
          if (l == 0) phase_norm<false>(A->xp, A->xs - (size_t)NTP * 1024, nullptr, A->g_mix + l * 1024, modl + 0 * 1024, modl + 1 * 1024, (bf16*)(ws + WS_H), tx, wv, nwv, lane, (7 * l + 0) & 1);
          else phase_norm<true>(nullptr, nullptr, (const bf16*)A->out, A->g_mix + l * 1024, modl + 0 * 1024, modl + 1 * 1024, (bf16*)(ws + WS_H), tx, wv, nwv, lane, (7 * l + 0) & 1); }
#endif
        GSYNC();
#if PH & 8
        REP(8)
        { FRAME(); LAYER(); pg8::Gemm g{(const bf16*)(ws + WS_H), (const bf16*)(wl + W_IN), NTOK, NPROJ, 1024}; const TeamOrder S{NPROJ / 256, tx, tr, tn, (7 * l + 1) & 1};
          pg8::EpiProj E{ws, A->q_gain + l * 64, A->k_gain + l * 64};
          pg8::gemm_phase<pg8::EpiProj, TeamOrder, true, true>(LDSP, g, S, E); }
#endif
        TSYNC();
#if PH & 16
        REP(16)
        { FRAME(); phase_attn(A->q_gain + l * 64, A->k_gain + l * 64, (const bf16*)(ws + WS_Q), (const bf16*)(ws + WS_K), (const bf16*)(ws + WS_V), (bf16*)(ws + WS_H), (char*)lds_raw, tx, tr, tn, lane, (7 * l + 2) & 1); }
#endif
#if PH & 32
        REP(32)
        { FRAME(); phase_conv((const bf16*)(ws + WS_BG), (const bf16*)(ws + WS_CU), A->conv_w + l * 3 * 512, (bf16*)(ws + WS_H), tx, wv, nwv, lane, (7 * l + 2) & 1); }
#endif
        TSYNC();
#if PH & 64
        { FRAME(); LAYER();
          pg8::Gemm g{(const bf16*)(ws + WS_H), (const bf16*)(wl + W_OUT), NTOK, 1024, 1024}; const TeamOrder S{4, tx, tr, tn, (7 * l + 3) & 1};
          pg8::EpiResid E{A->xp, A->xs - (size_t)NTP * 1024, (bf16*)A->out, modl + 2 * 1024, l == 0 ? 1 : 0};
          pg8::gemm_phase<pg8::EpiResid, TeamOrder, true, true>(LDSP, g, S, E); }
#endif
        TSYNC();
#if PH & 128
        REP(128)
        { FRAME(); LAYER(); phase_norm<true>(nullptr, nullptr, (const bf16*)A->out, A->g_ffn + l * 1024, modl + 3 * 1024, modl + 4 * 1024, (bf16*)(ws + WS_H), tx, wv, nwv, lane, (7 * l + 4) & 1); }
#endif
        GSYNC();
#if PH & 256
        REP(256)
        { FRAME(); LAYER(); pg8::Gemm g{(const bf16*)(ws + WS_H), (const bf16*)(wl + W_GU), NTOK, 2 * DFF, 1024}; const TeamOrder S{2 * DFF / 256, tx, tr, tn, (7 * l + 5) & 1};
          pg8::EpiSwiglu E{(bf16*)(ws + WS_F)};
          pg8::gemm_phase<pg8::EpiSwiglu, TeamOrder, true, true>(LDSP, g, S, E); }
#endif
        TSYNC();
#if PH & 512
        { FRAME(); LAYER(); pg8::Gemm g{(const bf16*)(ws + WS_F), (const bf16*)(wl + W_DN), NTOK, 1024, DFF}; const TeamOrder S{4, tx, tr, tn, (7 * l + 6) & 1};
          pg8::EpiResid E{nullptr, nullptr, (bf16*)A->out, modl + 5 * 1024, 0};
          pg8::gemm_phase<pg8::EpiResid, TeamOrder, true, true>(LDSP, g, S, E); }
#endif
        TSYNC();
    }
#if PH & 1024
    { FRAME(); phase_final_norm(A->out, A->g_final, tx, wv, nwv, lane); }
#endif
}

extern "C" void kernel_launch(void* const* d_in, const int* in_sizes, int n_in, void* d_out, int out_size, void* d_ws, size_t ws_size, hipStream_t stream) {
    static int grid = 0;
    if (grid == 0) {
        if (n_in != 17 || out_size != NTOK * 1024 || ws_size < WS_END) { fprintf(stderr, "kernel_launch: unexpected problem (n_in %d, out %d, ws %zu, need %zu)\n", n_in, out_size, ws_size, (size_t)WS_END); grid = -1; return; }
        int dev = 0, cus = 0, per_cu = 0;
        hipGetDevice(&dev); hipDeviceGetAttribute(&cus, hipDeviceAttributeMultiprocessorCount, dev);
        if (hipFuncSetAttribute((const void*)fwd_megakernel, hipFuncAttributeMaxDynamicSharedMemorySize, LDS_TOTAL) != hipSuccess) { fprintf(stderr, "kernel_launch: hipFuncSetAttribute failed\n"); grid = -1; return; }
        if (hipOccupancyMaxActiveBlocksPerMultiprocessor(&per_cu, (const void*)fwd_megakernel, NTHREADS, LDS_TOTAL) != hipSuccess || per_cu < 1) { fprintf(stderr, "kernel_launch: occupancy query failed (%d)\n", per_cu); (void)hipGetLastError(); per_cu = 1; }
        grid = cus * per_cu;
        if (grid > 256) grid = 256;
        if (grid % 8 != 0 || grid < 8) { fprintf(stderr, "kernel_launch: grid %d is not a multiple of 8 (the layer loop is organised in 8 teams)\n", grid); grid = -1; return; }
        fprintf(stderr, "kernel_launch: grid %d (cus %d, per_cu %d), ws %zu\n", grid, cus, per_cu, ws_size);
    }
    if (grid < 0) return;
    Args a{};
    a.xp = (const float*)d_in[0]; a.xs = (const float*)d_in[1]; a.cp = (const float*)d_in[2]; a.cs = (const float*)d_in[3];
    a.w_mod = (const float*)d_in[4]; a.b_mod = (const float*)d_in[5]; a.g_mix = (const float*)d_in[6]; a.w_in = (const float*)d_in[7];
    a.q_gain = (const float*)d_in[8]; a.k_gain = (const float*)d_in[9]; a.conv_w = (const float*)d_in[10]; a.w_out = (const float*)d_in[11];
    a.g_ffn = (const float*)d_in[12]; a.w_gate = (const float*)d_in[13]; a.w_up = (const float*)d_in[14]; a.w_down = (const float*)d_in[15]; a.g_final = (const float*)d_in[16];
    a.out = (float*)d_out; a.ws = (unsigned char*)d_ws; a.G = grid; a.pad = 0;
    if (hipMemsetAsync((char*)d_ws + WS_BAR, 0, WS_BAR_BYTES, stream) != hipSuccess) { fprintf(stderr, "kernel_launch: memset failed\n"); return; }
    void* args[] = {&a};
    hipError_t e = hipLaunchCooperativeKernel((const void*)fwd_megakernel, dim3(grid), dim3(NTHREADS), args, LDS_TOTAL, stream);
    if (e != hipSuccess) fprintf(stderr, "kernel_launch: cooperative launch failed: %s (grid %d)\n", hipGetErrorString(e), grid);
}
```

```cpp
#include <hip/hip_runtime.h>
#include <hip/hip_cooperative_groups.h>
#include <hip/hip_bf16.h>
#include <cstdio>
#include <cstdint>
#include <cmath>
namespace cg = cooperative_groups;
namespace pg8 {
#define PG8_LAS __attribute__((address_space(3)))
typedef unsigned short bf16_t;
typedef short bf16x8 __attribute__((ext_vector_type(8)));
typedef float f32x4 __attribute__((ext_vector_type(4)));
typedef unsigned u32x4 __attribute__((ext_vector_type(4)));
constexpr int BM = 256, BK = 64, HALF = 128, HTB = HALF * BK * 2  , STAGE_BYTES = 8 * HTB, NXCD = 8, WGM = 8;

__host__ __device__ __forceinline__ int lds_byte(int r, int c) { const int st = (r >> 4) * 2 + (c >> 5), rr = r & 15, cc = c & 31, ob = rr * 64 + cc * 2; return st * 1024 + (ob ^ (((ob >> 9) & 1) << 5)); }
__host__ __device__ __forceinline__ void stage_rc(int b, int& R, int& C) { const int st = b / 1024, sb = b % 1024, swz = sb ^ (((sb >> 9) & 1) << 5); R = (st >> 1) * 16 + swz / 64; C = (st & 1) * 32 + (swz % 64) / 2; }
__host__ __device__ __forceinline__ int perm32(int rho) { const int n = rho >> 4, i = rho & 15; return 8 * (i >> 2) + 4 * n + (i & 3); }

struct Unit { int pm, pn; };
struct Gemm { const bf16_t* A; const bf16_t* Bt; int M, N, K; };

struct StaticOrder {
    int nM, nN, nwg, G, c, rev;
    __host__ __device__ void init(int M, int N, int G_, int c_, int rev_ = 0) { nM = M / BM; nN = N / BM; nwg = nM * nN; G = G_; c = c_; rev = rev_; }
    __host__ __device__ bool next(int i, Unit& u) const {
        const long L = (long)i * G + c; if (L >= nwg) return false;
        int wgid = (int)L; { const int q = nwg / NXCD, r = nwg % NXCD, xcd = wgid % NXCD, off = wgid / NXCD; wgid = (xcd < r ? xcd * (q + 1) : r * (q + 1) + (xcd - r) * q) + off; }
        const int nig = WGM * nN, gid = wgid / nig, fm = gid * WGM, gsz = (nM - fm) < WGM ? (nM - fm) : WGM;
        u.pm = fm + ((wgid % nig) % gsz); u.pn = (wgid % nig) / gsz; if (rev) u.pm = nM - 1 - u.pm; return true;
    }
    __device__ __forceinline__ void a_ready(const Unit&) const {}
    __device__ __forceinline__ void done(const Unit&) const {}
};

__device__ __forceinline__ unsigned cvt_pk_bf16(float lo, float hi) { unsigned r; asm volatile("v_cvt_pk_bf16_f32 %0, %1, %2" : "=v"(r) : "v"(lo), "v"(hi)); return r; }
typedef float f32x2 __attribute__((ext_vector_type(2)));
constexpr size_t PMiB = 1u << 20, PWS_ROT = 0, PWS_Q = 308 * PMiB, PWS_K = PWS_Q + 128 * PMiB, PWS_V = PWS_K + 32 * PMiB, PWS_BG = PWS_V + 32 * PMiB, PWS_CU = PWS_BG + 128 * PMiB;
constexpr float QK_EPS = 1e-6f;
constexpr float ATT_C2 = 0.125f * 1.4426950408889634f;

struct EpiProj {
    static constexpr bool PERM = true, AFTER_DRAIN = false;
    unsigned char* ws; const float* qg; const float* kg;
    __device__ __forceinline__ void operator()(const f32x4 (&acc)[2][2][4][2], const Unit& u, int wr, int wc, int fr, int fq) const {
        const int pn = u.pn; const int row0 = u.pm * BM + wr * 64 + fr;
        bf16_t* const Q = (bf16_t*)(ws + PWS_Q); bf16_t* const Kb = (bf16_t*)(ws + PWS_K); bf16_t* const Vb = (bf16_t*)(ws + PWS_V); bf16_t* const Bg = (bf16_t*)(ws + PWS_BG); bf16_t* const CU = (bf16_t*)(ws + PWS_CU); const float* const rot = (const float*)(ws + PWS_ROT);
        if (pn >= 5) {
            bf16_t* base = CU + (size_t)row0 * 512 + (pn - 5) * 128 + wc * 32 + fq * 8;
#pragma unroll
            for (int ai = 0; ai < 2; ++ai)
#pragma unroll
                for (int m = 0; m < 4; ++m) { const f32x4 v0 = acc[ai][0][m][0] * acc[ai][1][m][0], v1 = acc[ai][0][m][1] * acc[ai][1][m][1];
                    u32x4 w; w.x = cvt_pk_bf16(v0[0], v0[1]); w.y = cvt_pk_bf16(v0[2], v0[3]); w.z = cvt_pk_bf16(v1[0], v1[1]); w.w = cvt_pk_bf16(v1[2], v1[3]);
                    *(u32x4*)(base + (size_t)(ai * HALF + m * 16) * 512) = w; }
            return;
        }
        const bool is_q = pn < 2, is_k = (pn == 2) && (wc < 2), is_v = (pn == 2) && (wc >= 2);
        bf16_t* base; int pitch;
        if (is_q) { base = Q + pn * 256 + wc * 64; pitch = 512; }
        else if (is_k) { base = Kb + wc * 64; pitch = 128; }
        else if (is_v) { base = Vb + (wc - 2) * 64; pitch = 128; }
        else { base = Bg + (pn - 3) * 256 + wc * 64; pitch = 512; }
        base += (size_t)row0 * pitch + fq * 8;
        if (is_q || is_k) {
            const float* gp = (is_q ? qg : kg) + fq * 8; const float osc = is_q ? ATT_C2 : 1.0f;
            f32x4 gv[2][2];
#pragma unroll
            for (int bj = 0; bj < 2; ++bj)
#pragma unroll
                for (int n = 0; n < 2; ++n) gv[bj][n] = *(const f32x4*)(gp + bj * 32 + n * 4) * osc;
#pragma unroll
            for (int ai = 0; ai < 2; ++ai)
#pragma unroll
                for (int m = 0; m < 4; ++m) {
                    float ss = 0.f;
#pragma unroll
                    for (int bj = 0; bj < 2; ++bj)
#pragma unroll
                        for (int n = 0; n < 2; ++n) { const f32x4 x = acc[ai][bj][m][n]; ss += (x[0] * x[0] + x[1] * x[1]) + (x[2] * x[2] + x[3] * x[3]); }
                    ss += __shfl_xor(ss, 16); ss += __shfl_xor(ss, 32);
                    const float rstd = __builtin_amdgcn_rsqf(ss * (1.0f / 64.0f) + QK_EPS);
                    const int t = row0 + ai * HALF + m * 16;
                    const int prow = (t < 65536) ? ((t >> 6) & 127) : ((t >> 6) & 63), pcol = t & 63;
#pragma unroll
                    for (int bj = 0; bj < 2; ++bj) {
                        const float* rp = rot + ((bj ? pcol : prow) * 16 + fq * 4) * 2;
                        f32x4 o[2];
#pragma unroll
                        for (int n = 0; n < 2; ++n) { const f32x4 cs = *(const f32x4*)(rp + n * 4); const f32x4 x = acc[ai][bj][m][n] * rstd * gv[bj][n];
                            o[n][0] = x[0] * cs[0] - x[1] * cs[1]; o[n][1] = x[0] * cs[1] + x[1] * cs[0]; o[n][2] = x[2] * cs[2] - x[3] * cs[3]; o[n][3] = x[2] * cs[3] + x[3] * cs[2]; }
                        u32x4 w; w.x = cvt_pk_bf16(o[0][0], o[0][1]); w.y = cvt_pk_bf16(o[0][2], o[0][3]); w.z = cvt_pk_bf16(o[1][0], o[1][1]); w.w = cvt_pk_bf16(o[1][2], o[1][3]);
                        *(u32x4*)(base + (size_t)(ai * HALF + m * 16) * pitch + bj * 32) = w; }
                }
        } else {
#pragma unroll
            for (int ai = 0; ai < 2; ++ai)
#pragma unroll
                for (int m = 0; m < 4; ++m)
#pragma unroll
                    for (int bj = 0; bj < 2; ++bj) { const f32x4 v0 = acc[ai][bj][m][0], v1 = acc[ai][bj][m][1];
                        u32x4 w; w.x = cvt_pk_bf16(v0[0], v0[1]); w.y = cvt_pk_bf16(v0[2], v0[3]); w.z = cvt_pk_bf16(v1[0], v1[1]); w.w = cvt_pk_bf16(v1[2], v1[3]);
                        *(u32x4*)(base + (size_t)(ai * HALF + m * 16) * pitch + bj * 32) = w; }
        }
    }
};
struct EpiResid {
    static constexpr bool PERM = true, AFTER_DRAIN = false;
    const float* xa; const float* xb; bf16_t* res; const float* gate; int in_f32;
    __device__ __forceinline__ void operator()(const f32x4 (&acc)[2][2][4][2], const Unit& u, int wr, int wc, int fr, int fq) const {
        const int rowt = u.pm * BM; const int b = rowt < 65536 ? (rowt >> 13) : 8 + ((rowt - 65536) >> 12);
        const float* xin = rowt < 65536 ? xa : xb;
        const int row0 = rowt + wr * 64 + fr, col0 = u.pn * BM + wc * 32 + fq * 8;
        f32x4 gv[2][2];
#pragma unroll
        for (int bj = 0; bj < 2; ++bj)
#pragma unroll
            for (int n = 0; n < 2; ++n) gv[bj][n] = *(const f32x4*)(gate + (size_t)b * 6144 + col0 + bj * HALF + n * 4);
        if (in_f32) {
#pragma unroll
            for (int ai = 0; ai < 2; ++ai)
#pragma unroll
                for (int mp = 0; mp < 2; ++mp) { f32x4 x[2][2][2];
#pragma unroll
                    for (int mm = 0; mm < 2; ++mm)
#pragma unroll
                        for (int bj = 0; bj < 2; ++bj) { const float* p = xin + (size_t)(row0 + ai * HALF + (2 * mp + mm) * 16) * 1024 + col0 + bj * HALF; x[mm][bj][0] = *(const f32x4*)p; x[mm][bj][1] = *(const f32x4*)(p + 4); }
#pragma unroll
                    for (int mm = 0; mm < 2; ++mm)
#pragma unroll
                        for (int bj = 0; bj < 2; ++bj) { const int m = 2 * mp + mm; const f32x4 y0 = x[mm][bj][0] + gv[bj][0] * acc[ai][bj][m][0], y1 = x[mm][bj][1] + gv[bj][1] * acc[ai][bj][m][1];
                            u32x4 w; w.x = cvt_pk_bf16(y0[0], y0[1]); w.y = cvt_pk_bf16(y0[2], y0[3]); w.z = cvt_pk_bf16(y1[0], y1[1]); w.w = cvt_pk_bf16(y1[2], y1[3]);
                            *(u32x4*)(res + (size_t)(row0 + ai * HALF + m * 16) * 2048 + col0 + bj * HALF) = w; }
                    asm volatile("" ::: "memory"); }
        } else {
#pragma unroll
            for (int ai = 0; ai < 2; ++ai) { u32x4 p[4][2];
#pragma unroll
                for (int m = 0; m < 4; ++m)
#pragma unroll
                    for (int bj = 0; bj < 2; ++bj) p[m][bj] = *(const u32x4*)(res + (size_t)(row0 + ai * HALF + m * 16) * 2048 + col0 + bj * HALF);
#pragma unroll
                for (int m = 0; m < 4; ++m)
#pragma unroll
                    for (int bj = 0; bj < 2; ++bj) { const u32x4 q = p[m][bj];
                        const f32x4 x0 = (f32x4){__uint_as_float(q.x << 16), __uint_as_float(q.x & 0xffff0000u), __uint_as_float(q.y << 16), __uint_as_float(q.y & 0xffff0000u)};
                        const f32x4 x1 = (f32x4){__uint_as_float(q.z << 16), __uint_as_float(q.z & 0xffff0000u), __uint_as_float(q.w << 16), __uint_as_float(q.w & 0xffff0000u)};
                        const f32x4 y0 = x0 + gv[bj][0] * acc[ai][bj][m][0], y1 = x1 + gv[bj][1] * acc[ai][bj][m][1];
                        u32x4 w; w.x = cvt_pk_bf16(y0[0], y0[1]); w.y = cvt_pk_bf16(y0[2], y0[3]); w.z = cvt_pk_bf16(y1[0], y1[1]); w.w = cvt_pk_bf16(y1[2], y1[3]);
                        *(u32x4*)(res + (size_t)(row0 + ai * HALF + m * 16) * 2048 + col0 + bj * HALF) = w; }
                asm volatile("" ::: "memory"); }
        }
    }
};
struct EpiSwiglu {
    static constexpr bool PERM = true, AFTER_DRAIN = false;
    bf16_t* Hd;
    __device__ __forceinline__ void operator()(const f32x4 (&acc)[2][2][4][2], const Unit& u, int wr, int wc, int fr, int fq) const {
        bf16_t* base = Hd + (size_t)(u.pm * BM + wr * 64 + fr) * 2816 + u.pn * 128 + wc * 32 + fq * 8;
#pragma unroll
        for (int ai = 0; ai < 2; ++ai)
#pragma unroll
            for (int m = 0; m < 4; ++m) { f32x4 o[2];
#pragma unroll
                for (int n = 0; n < 2; ++n) { const f32x4 g = acc[ai][0][m][n], up = acc[ai][1][m][n];
#pragma unroll
                    for (int e = 0; e < 4; ++e) { const float ex = __builtin_amdgcn_exp2f(g[e] * -1.4426950408889634f); o[n][e] = g[e] * __builtin_amdgcn_rcpf(1.0f + ex) * up[e]; } }
                u32x4 w; w.x = cvt_pk_bf16(o[0][0], o[0][1]); w.y = cvt_pk_bf16(o[0][2], o[0][3]); w.z = cvt_pk_bf16(o[1][0], o[1][1]); w.w = cvt_pk_bf16(o[1][2], o[1][3]);
                *(u32x4*)(base + (size_t)(ai * HALF + m * 16) * 2816) = w; }
    }
};
template <class Epi, class Sched, bool ALIGN_EPI = false, bool SP2 = false>
__device__ __forceinline__ void gemm_phase(PG8_LAS unsigned char* lds, const Gemm g, const Sched& S, const Epi& E) {
    int tid_l = threadIdx.x; asm volatile("" : "+v"(tid_l));
    const int tid = tid_l, wid = __builtin_amdgcn_readfirstlane(tid >> 6), lane = tid & 63, wr = wid >> 2, wc = wid & 3, fr = lane & 15, fq = lane >> 4;
    const int K = g.K, nt = K / BK;
    unsigned voffA[2], voffB[2];
#pragma unroll
    for (int i = 0; i < 2; ++i) { int R, C; stage_rc(tid * 16 + i * 8192, R, C); const int Rb = Epi::PERM ? ((R & ~31) + perm32(R & 31)) : R;
        voffA[i] = (unsigned)(R * K + C) * 2u; voffB[i] = (unsigned)(Rb * K + C) * 2u; }
    const size_t kstep = (size_t)(BK * 2);
    const size_t hstep = (size_t)HALF * K * 2;
    const size_t tstep = 2 * hstep;
    const unsigned ldsw = (unsigned)wid * 1024u;
    const int aoff = lds_byte(wr * 64 + fr, fq * 8), boff = lds_byte(wc * 32 + fr, fq * 8);
#define PG8_SA(b, h) (((b) * 2 + (h)) * HTB)
#define PG8_SB(b, h) ((4 + (b) * 2 + (h)) * HTB)
#define PG8_STAGE(bufoff, gbase, voff) do { _Pragma("unroll") for (int _i = 0; _i < 2; ++_i) \
        __builtin_amdgcn_global_load_lds((const unsigned*)((const char*)(gbase) + (voff)[_i]), (PG8_LAS unsigned*)(lds + (bufoff) + ldsw + _i * 8192), 16, 0, 0); } while (0)
#define PG8_LDA(dst, b, h) do { _Pragma("unroll") for (int m = 0; m < 4; ++m) _Pragma("unroll") for (int k = 0; k < 2; ++k) dst[m][k] = *(const PG8_LAS bf16x8*)(lds + PG8_SA(b, h) + aoff + m * 2048 + k * 1024); } while (0)
#define PG8_LDB(dst, b, h) do { _Pragma("unroll") for (int n = 0; n < 2; ++n) _Pragma("unroll") for (int k = 0; k < 2; ++k) dst[n][k] = *(const PG8_LAS bf16x8*)(lds + PG8_SB(b, h) + boff + n * 2048 + k * 1024); } while (0)
#define PG8_MMA(ai, bj, At, Bt) do { __builtin_amdgcn_s_setprio(1); _Pragma("unroll") for (int m = 0; m < 4; ++m) _Pragma("unroll") for (int n = 0; n < 2; ++n) _Pragma("unroll") for (int k = 0; k < 2; ++k) \
        acc[ai][bj][m][n] = __builtin_amdgcn_mfma_f32_16x16x32_bf16(Bt[n][k], At[m][k], acc[ai][bj][m][n], 0, 0, 0); __builtin_amdgcn_s_setprio(0); } while (0)
#define PG8_WAIT_V(n) asm volatile("s_waitcnt vmcnt(" #n ")" ::: "memory")
#define PG8_WAIT_L(n) asm volatile("s_waitcnt lgkmcnt(" #n ")" ::: "memory")
#define PG8_BAR __builtin_amdgcn_s_barrier()
#define PG8_SCHED __builtin_amdgcn_sched_barrier(0)
    Unit cur, nxt; int ui = 0;
    if (!S.next(0, cur)) return;
    f32x4 acc[2][2][4][2];
#pragma unroll
    for (int a = 0; a < 2; ++a)
#pragma unroll
        for (int b = 0; b < 2; ++b)
#pragma unroll
            for (int m = 0; m < 4; ++m)
#pragma unroll
                for (int n = 0; n < 2; ++n) acc[a][b][m][n] = (f32x4){0.f, 0.f, 0.f, 0.f};
    bf16x8 At[4][2], B0[2][2], B1[2][2];
    const char* cA = (const char*)g.A + (size_t)cur.pm * tstep; const char* cB = (const char*)g.Bt + (size_t)cur.pn * tstep;
    S.a_ready(cur);
    if constexpr (SP2) {
        PG8_STAGE(PG8_SB(0, 0), cB, voffB); PG8_STAGE(PG8_SB(0, 1), cB + hstep, voffB); PG8_STAGE(PG8_SA(0, 0), cA, voffA); PG8_STAGE(PG8_SA(0, 1), cA + hstep, voffA);
        if (wr == 1) PG8_BAR;
        PG8_WAIT_V(2); PG8_BAR;
        PG8_STAGE(PG8_SB(1, 0), cB + kstep, voffB); PG8_STAGE(PG8_SA(1, 0), cA + kstep, voffA); PG8_STAGE(PG8_SB(1, 1), cB + hstep + kstep, voffB);
        PG8_WAIT_V(6); PG8_BAR;
    } else {
        PG8_STAGE(PG8_SB(0, 0), cB, voffB); PG8_STAGE(PG8_SA(0, 0), cA, voffA); PG8_STAGE(PG8_SB(0, 1), cB + hstep, voffB); PG8_STAGE(PG8_SA(0, 1), cA + hstep, voffA);
        if (wr == 1) PG8_BAR;
        PG8_WAIT_V(4); PG8_BAR;
        PG8_STAGE(PG8_SB(1, 0), cB + kstep, voffB); PG8_STAGE(PG8_SA(1, 0), cA + kstep, voffA); PG8_STAGE(PG8_SB(1, 1), cB + hstep + kstep, voffB);
        PG8_WAIT_V(6); PG8_BAR;
    }
    for (;;) {
        const bool has_next = S.next(ui + 1, nxt);
        const char* nA = has_next ? (const char*)g.A + (size_t)nxt.pm * tstep : cA; const char* nB = has_next ? (const char*)g.Bt + (size_t)nxt.pn * tstep : cB;
        for (int t = 0; t < nt; t += 2) {
            const bool last = (t == nt - 2);
            const char* a1 = cA + (size_t)(t + 1) * kstep;
            const char* a2 = last ? nA : cA + (size_t)(t + 2) * kstep; const char* b2 = last ? nB : cB + (size_t)(t + 2) * kstep;
            const char* a3 = a2 + kstep; const char* b3 = b2 + kstep;
            if (last && has_next) S.a_ready(nxt);
            if constexpr (SP2) {
            PG8_LDB(B0, 0, 0); PG8_LDB(B1, 0, 1); PG8_SCHED; PG8_LDA(At, 0, 0); PG8_STAGE(PG8_SA(1, 1), a1 + hstep, voffA);
            PG8_WAIT_V(8); PG8_WAIT_L(0); PG8_BAR; PG8_MMA(0, 0, At, B0); PG8_MMA(0, 1, At, B1); PG8_BAR; PG8_SCHED;
            PG8_LDA(At, 0, 1); PG8_STAGE(PG8_SB(0, 0), b2, voffB); PG8_STAGE(PG8_SB(0, 1), b2 + hstep, voffB); PG8_STAGE(PG8_SA(0, 0), a2, voffA);
            PG8_WAIT_V(8); PG8_WAIT_L(0); PG8_BAR; PG8_MMA(1, 0, At, B0); PG8_MMA(1, 1, At, B1); PG8_BAR; PG8_SCHED;
            PG8_LDB(B0, 1, 0); PG8_LDB(B1, 1, 1); PG8_SCHED; PG8_LDA(At, 1, 0); PG8_STAGE(PG8_SA(0, 1), a2 + hstep, voffA);
            PG8_WAIT_V(8); PG8_WAIT_L(0); PG8_BAR; PG8_MMA(0, 0, At, B0); PG8_MMA(0, 1, At, B1); PG8_BAR; PG8_SCHED;
            PG8_LDA(At, 1, 1); PG8_STAGE(PG8_SB(1, 0), b3, voffB); PG8_STAGE(PG8_SB(1, 1), b3 + hstep, voffB); PG8_STAGE(PG8_SA(1, 0), a3, voffA);
            PG8_WAIT_V(8); PG8_WAIT_L(0); PG8_BAR; PG8_MMA(1, 0, At, B0); PG8_MMA(1, 1, At, B1); PG8_BAR; PG8_SCHED;
            } else {
            PG8_LDB(B0, 0, 0); PG8_SCHED; PG8_LDA(At, 0, 0); PG8_STAGE(PG8_SA(1, 1), a1 + hstep, voffA);
            PG8_WAIT_L(8); PG8_BAR; PG8_WAIT_L(0); PG8_MMA(0, 0, At, B0); PG8_BAR; PG8_SCHED;
            PG8_LDB(B1, 0, 1); PG8_STAGE(PG8_SB(0, 0), b2, voffB);
            PG8_BAR; PG8_WAIT_L(0); PG8_MMA(0, 1, At, B1); PG8_BAR;
            PG8_LDA(At, 0, 1); PG8_STAGE(PG8_SA(0, 0), a2, voffA);
            PG8_BAR; PG8_WAIT_L(0); PG8_MMA(1, 0, At, B0); PG8_BAR; PG8_SCHED;
            PG8_STAGE(PG8_SB(0, 1), b2 + hstep, voffB);
            PG8_WAIT_V(6); PG8_BAR; PG8_MMA(1, 1, At, B1); PG8_BAR;
            PG8_LDB(B0, 1, 0); PG8_SCHED; PG8_LDA(At, 1, 0); PG8_STAGE(PG8_SA(0, 1), a2 + hstep, voffA);
            PG8_WAIT_L(8); PG8_BAR; PG8_WAIT_L(0); PG8_MMA(0, 0, At, B0); PG8_BAR; PG8_SCHED;
            PG8_LDB(B1, 1, 1); PG8_STAGE(PG8_SB(1, 0), b3, voffB);
            PG8_BAR; PG8_WAIT_L(0); PG8_MMA(0, 1, At, B1); PG8_BAR;
            PG8_LDA(At, 1, 1); PG8_STAGE(PG8_SA(1, 0), a3, voffA);
            PG8_BAR; PG8_WAIT_L(0); PG8_MMA(1, 0, At, B0); PG8_BAR; PG8_SCHED;
            PG8_STAGE(PG8_SB(1, 1), b3 + hstep, voffB);
            PG8_WAIT_V(6); PG8_BAR; PG8_MMA(1, 1, At, B1); PG8_BAR;
            }
        }
        if constexpr (ALIGN_EPI) { if (wr == 0) PG8_BAR; }
        if constexpr (!Epi::AFTER_DRAIN) { E(acc, cur, wr, wc, fr, fq); S.done(cur); }
        if (!has_next) break;
#pragma unroll
        for (int a = 0; a < 2; ++a)
#pragma unroll
            for (int b = 0; b < 2; ++b)
#pragma unroll
                for (int m = 0; m < 4; ++m)
#pragma unroll
                    for (int n = 0; n < 2; ++n) acc[a][b][m][n] = (f32x4){0.f, 0.f, 0.f, 0.f};
        cur = nxt; cA = nA; cB = nB; ++ui;
        if constexpr (ALIGN_EPI) { if (wr == 1) PG8_BAR; }
    }
    PG8_WAIT_V(0);
    if constexpr (!ALIGN_EPI) { if (wr == 0) PG8_BAR; }
    PG8_BAR;
    if constexpr (Epi::AFTER_DRAIN) { E.fused(acc, cur, wr, wc, fr, fq, lds, wid, lane); S.done(cur); }
#undef PG8_SA
#undef PG8_SB
#undef PG8_STAGE
#undef PG8_LDA
#undef PG8_LDB
#undef PG8_MMA
#undef PG8_WAIT_V
#undef PG8_WAIT_L
#undef PG8_BAR
#undef PG8_SCHED
}
}
namespace attn_body {
using bf16=__hip_bfloat16;
using bf16x8=__attribute__((ext_vector_type(8)))short;
using s16x4=__attribute__((ext_vector_type(4)))short;
using f32x16=__attribute__((ext_vector_type(16)))float;
using u32x4=__attribute__((ext_vector_type(4)))unsigned;
constexpr int D=64,QP=512,KP=128,OP=1024;
constexpr int NW=8,QBLK=32,QB=QBLK*NW,KVBLK=64;
__device__ __forceinline__ int crow(int r,int hi){return (r&3)+8*(r>>2)+4*hi;}
#define SBAR() __builtin_amdgcn_sched_barrier(0)
constexpr int NSLOT=3, SLOTB=8192;
constexpr int LDS_K=0, LDS_V=NSLOT*SLOTB, LDS_WS=2*NSLOT*SLOTB, LDS_OST=LDS_WS+NW*64*4, LDS_BYTES=LDS_OST+NW*4096;
constexpr float C2=0.125f*1.4426950408889634f;
__device__ __forceinline__ void glds16(const void*gsrc,unsigned lds_dst){unsigned keep;
  asm volatile("s_mov_b32 %0, m0\n\ts_mov_b32 m0, %2\n\ts_nop 0\n\tglobal_load_lds_dwordx4 %1, off\n\ts_mov_b32 m0, %0":"=&s"(keep):"v"(gsrc),"s"(lds_dst):"memory");}
__device__ __forceinline__ float max3f(float a,float b,float c){float r;asm("v_max3_f32 %0, %1, %2, %3":"=v"(r):"v"(a),"v"(b),"v"(c));return r;}
__device__ __forceinline__ float max2f(float a,float b){float r;asm("v_max_f32_e32 %0, %1, %2":"=v"(r):"v"(a),"v"(b));return r;}
__device__ __forceinline__ float fadd_s(float a,float b){float r;asm("v_add_f32_e32 %0, %1, %2":"=v"(r):"v"(a),"v"(b));return r;}
__device__ __forceinline__ float fsub_s(float a,float b){float r;asm("v_sub_f32_e32 %0, %1, %2":"=v"(r):"v"(a),"v"(b));return r;}
typedef float f32x2_t __attribute__((ext_vector_type(2))); typedef __bf16 bf16x2_t __attribute__((ext_vector_type(2)));
__device__ __forceinline__ unsigned cvtpk_s(float lo,float hi){f32x2_t v={lo,hi};bf16x2_t b=__builtin_convertvector(v,bf16x2_t);return __builtin_bit_cast(unsigned,b);}
#define WAIT_BAR(N) asm volatile("s_waitcnt vmcnt(" #N ") lgkmcnt(0)\n\ts_barrier":::"memory")

__device__ __forceinline__ void qkt(f32x16&p0,f32x16&p1,const char*Kslot,const bf16x8*qr,const f32x16&negm,int r32,int hi){
  const char*kb=Kslot+hi*1024+r32*16;
  #pragma unroll
  for(int d0=0;d0<4;++d0){
    const bf16x8 b0=*reinterpret_cast<const bf16x8*>(kb+d0*2048);
    const bf16x8 b1=*reinterpret_cast<const bf16x8*>(kb+d0*2048+512);
    if(d0==0){p0=__builtin_amdgcn_mfma_f32_32x32x16_bf16(b0,qr[0],negm,0,0,0);p1=__builtin_amdgcn_mfma_f32_32x32x16_bf16(b1,qr[0],negm,0,0,0);}
    else{p0=__builtin_amdgcn_mfma_f32_32x32x16_bf16(b0,qr[d0],p0,0,0,0);p1=__builtin_amdgcn_mfma_f32_32x32x16_bf16(b1,qr[d0],p1,0,0,0);}}
}
typedef __attribute__((address_space(3))) const char* lds_cptr;
typedef short v4i16_t __attribute__((ext_vector_type(4)));
__device__ __forceinline__ void kload8(bf16x8*kf,lds_cptr kp){
  kf[0]=*(const __attribute__((address_space(3))) bf16x8*)(kp);      kf[1]=*(const __attribute__((address_space(3))) bf16x8*)(kp+512);
  kf[2]=*(const __attribute__((address_space(3))) bf16x8*)(kp+2048); kf[3]=*(const __attribute__((address_space(3))) bf16x8*)(kp+2560);
  kf[4]=*(const __attribute__((address_space(3))) bf16x8*)(kp+4096); kf[5]=*(const __attribute__((address_space(3))) bf16x8*)(kp+4608);
  kf[6]=*(const __attribute__((address_space(3))) bf16x8*)(kp+6144); kf[7]=*(const __attribute__((address_space(3))) bf16x8*)(kp+6656);
}
__device__ __forceinline__ void kload2(bf16x8*kf,lds_cptr kp,int j){ kf[2*j]=*(const __attribute__((address_space(3))) bf16x8*)(kp+j*2048); kf[2*j+1]=*(const __attribute__((address_space(3))) bf16x8*)(kp+j*2048+512); }
__device__ __forceinline__ s16x4 vtr(lds_cptr p){ return __builtin_bit_cast(s16x4,__builtin_amdgcn_ds_read_tr16_b64_v4i16((__attribute__((address_space(3))) v4i16_t*)p)); }
__device__ __forceinline__ float rowmax(const f32x16&p0,const f32x16&p1){
  float a=max3f(p0[0],p0[1],p1[0]),b=max3f(p0[2],p0[3],p1[1]);a=max3f(a,p1[2],p1[3]);
  #pragma unroll
  for(int r=4;r<16;r+=4){a=max3f(a,p0[r],p0[r+1]);b=max3f(b,p0[r+2],p0[r+3]);a=max3f(a,p1[r],p1[r+1]);b=max3f(b,p1[r+2],p1[r+3]);}
  const float m=max2f(a,b);
  auto rr=__builtin_amdgcn_permlane32_swap(__float_as_uint(m),__float_as_uint(m),false,false);
  return max2f(__uint_as_float(rr[0]),__uint_as_float(rr[1]));
}
__device__ __forceinline__ void pv(f32x16*o,int vb,bf16x8 pa0,bf16x8 pa1,bf16x8 pa2,bf16x8 pa3){
  #pragma unroll
  for(int d0=0;d0<2;++d0){s16x4 lo[4],hi[4];
    #pragma unroll
    for(int ks=0;ks<4;++ks){
      asm volatile("ds_read_b64_tr_b16 %0,%1 offset:%c2":"=&v"(lo[ks]):"v"(vb),"i"(d0*4096+ks*1024):"memory");
      asm volatile("ds_read_b64_tr_b16 %0,%1 offset:%c2":"=&v"(hi[ks]):"v"(vb),"i"(d0*4096+ks*1024+512):"memory");}
    asm volatile("s_waitcnt lgkmcnt(0)":::"memory");SBAR();
    #define PK(k) (bf16x8){lo[k][0],lo[k][1],lo[k][2],lo[k][3],hi[k][0],hi[k][1],hi[k][2],hi[k][3]}
    o[d0]=__builtin_amdgcn_mfma_f32_32x32x16_bf16(pa0,PK(0),o[d0],0,0,0);
    o[d0]=__builtin_amdgcn_mfma_f32_32x32x16_bf16(pa1,PK(1),o[d0],0,0,0);
    o[d0]=__builtin_amdgcn_mfma_f32_32x32x16_bf16(pa2,PK(2),o[d0],0,0,0);
    o[d0]=__builtin_amdgcn_mfma_f32_32x32x16_bf16(pa3,PK(3),o[d0],0,0,0);
    #undef PK
  }
}

#ifndef ATTN_STORE16
#define ATTN_STORE16(p,v) (*(u32x4*)(p)=(v))
#endif
template<int THRL,bool SREF> __device__ __forceinline__ void attn_unit(float mref,long rowbase,int S,int h,int kvh,int qb,const bf16*Q,const bf16*__restrict__ K,const bf16*__restrict__ V,bf16*O,char*shm){
  int tid_l=threadIdx.x; asm volatile("":"+v"(tid_l));
  const int tid=tid_l,lane=tid&63,r32=lane&31,hi=lane>>5; const int wid=__builtin_amdgcn_readfirstlane(tid>>6);
  const int q0=qb*QB;
  const bf16*Qw=Q+(rowbase+q0+wid*QBLK)*QP+h*D;
  const bf16*Kh=K+rowbase*KP+kvh*D,*Vh=V+rowbase*KP+kvh*D;
  const unsigned lds0=(unsigned)(uintptr_t)shm;
  float*wsf=(float*)(shm+LDS_WS)+wid*64;
  const bf16*ksrc=Kh+(long)lane*KP+wid*8;
  const bf16*vsrc=Vh+(long)(16*(wid&3)+(lane>>2))*KP+(wid>>2)*32+(lane&3)*8;
  const unsigned kdst=lds0+LDS_K+wid*1024, vdst=lds0+LDS_V+wid*1024;
  #define DMA_K(t,slot) glds16(ksrc+(long)(t)*KVBLK*KP,(unsigned)__builtin_amdgcn_readfirstlane(kdst+(slot)))
  #define DMA_V(t,slot) glds16(vsrc+(long)(t)*KVBLK*KP,(unsigned)__builtin_amdgcn_readfirstlane(vdst+(slot)))
  const int vb0=(int)(lds0+LDS_V)+((lane>>4)&1)*32+(lane&3)*8+(4*hi+((lane&15)>>2))*64;
  const char*Kbase=shm+LDS_K; bf16x8 kf[8];
  const lds_cptr shm3=(lds_cptr)shm; const lds_cptr kp0=shm3+LDS_K+hi*1024+r32*16; const lds_cptr vp0=shm3+LDS_V+((lane>>4)&1)*32+(lane&3)*8+(4*hi+((lane&15)>>2))*64;
  const int NT=S/KVBLK;
  DMA_K(0,0);DMA_V(0,0);DMA_K(1,SLOTB);
  bf16x8 qr[4];
  #pragma unroll
  for(int d0=0;d0<4;++d0)qr[d0]=*reinterpret_cast<const bf16x8*>(&Qw[(long)r32*QP+d0*16+hi*8]);
  float mhat=0.f,l_reg=0.f;f32x16 o[2];o[0]=f32x16{};o[1]=f32x16{};f32x16 negm=f32x16{}; if constexpr(SREF){ _Pragma("unroll") for(int r=0;r<16;++r)negm[r]=-mref; } asm volatile("":"+v"(negm));
  #define CMASK(P0,P1,t) do{}while(0)
  bool resc=false;
  #define START(P0,P1) do{ resc=false; \
    if constexpr(!SREF){ const float rm=rowmax(P0,P1); const float dl=rm; mhat=fadd_s(mhat,dl); \
      _Pragma("unroll") for(int r=0;r<16;++r){P0[r]=fsub_s(P0[r],dl);P1[r]=fsub_s(P1[r],dl);} \
      _Pragma("unroll") for(int r=0;r<16;++r)negm[r]=-mhat; asm volatile("":"+v"(negm)); } \
    _Pragma("unroll") for(int r=0;r<16;++r)P0[r]=__builtin_amdgcn_exp2f(P0[r]); }while(0)
  #define RESC() do{ if constexpr(!SREF) if(resc){ asm volatile("s_waitcnt lgkmcnt(0)":::"memory"); \
      _Pragma("unroll") for(int d_=0;d_<2;++d_) _Pragma("unroll") for(int r=0;r<16;++r)o[d_][r]*=wsf[crow(r,hi)]; } }while(0)
  f32x16 pA0,pA1,pB0,pB1;
  int sl_prev=0,sl_cur=0,sl_next=SLOTB;
  #define ROT() do{sl_prev=sl_cur;sl_cur=sl_next;sl_next=(sl_next==(NSLOT-1)*SLOTB)?0:sl_next+SLOTB;}while(0)
  DMA_K(2,2*SLOTB);
  WAIT_BAR(3);
  qkt(pA0,pA1,Kbase,qr,negm,r32,hi);asm volatile("s_nop 15\n\ts_nop 7":"+v"(pA0),"+v"(pA1));CMASK(pA0,pA1,0);
  START(pA0,pA1);
  _Pragma("unroll") for(int r=0;r<16;++r)pA1[r]=__builtin_amdgcn_exp2f(pA1[r]);
  WAIT_BAR(0);
  DMA_K(3,0);DMA_V(1,SLOTB);
  ROT();
  kload8(kf,kp0+sl_cur);
  WAIT_BAR(2);
  s16x4 vlo[8],vhi[8]; u32x4 pw0,pw1,pw2,pw3;
  #define PKW(P,B) cvtpk_s(P[B],P[B+1])
  #define PAF(k) __builtin_bit_cast(bf16x8,pw##k)
  #define VFR(i) (bf16x8){vlo[i][0],vlo[i][1],vlo[i][2],vlo[i][3],vhi[i][0],vhi[i][1],vhi[i][2],vhi[i][3]}
  #define PIN(x) asm volatile("":"+v"(x))
  #define MX3(a,b,c) __builtin_fmaxf(__builtin_fmaxf((a),(b)),(c))
  #define GAPA(MF,A0,A1,A2,A3,W0,W1,PW) do{ MF; sacc+=A0; sacc+=A1; sacc+=A2; sacc+=A3; PIN(sacc); W0; W1; PIN(PW); SBAR(); }while(0)
  #define EX(v) __builtin_amdgcn_exp2f(v)
  #define GAPB(MF,X,B) do{ MF; X[B]=EX(X[B]); X[B+1]=EX(X[B+1]); X[B+2]=EX(X[B+2]); X[B+3]=EX(X[B+3]); PIN(X); SBAR(); }while(0)
  #define VRD(i) do{ vlo[i]=vtr(vp_+(((i)>>2)*4096+((i)&3)*1024)); vhi[i]=vtr(vp_+(((i)>>2)*4096+((i)&3)*1024+512)); }while(0)
  #define KRD(G,j) do{ if(G){ kload2(kf,kp0+sl_next,j); SBAR(); } }while(0)
  #define STEP(C0,C1,P0,P1,t,GK,GV,GL) do{ SBAR(); \
    const lds_cptr vp_=vp0+sl_prev; \
    VRD(0); SBAR(); float sacc=(P0[0]+P0[1]); \
    GAPA(C0=__builtin_amdgcn_mfma_f32_32x32x16_bf16(kf[0],qr[0],negm,0,0,0), P0[2],P0[3],P0[4],P0[5],     pw0[0]=PKW(P0,0), pw0[1]=PKW(P0,2), pw0); \
    VRD(4); SBAR(); GAPA(C1=__builtin_amdgcn_mfma_f32_32x32x16_bf16(kf[1],qr[0],negm,0,0,0), P0[6],P0[7],P0[8],P0[9],     pw0[2]=PKW(P0,4), pw0[3]=PKW(P0,6), pw0); \
    VRD(1); SBAR(); GAPA(C0=__builtin_amdgcn_mfma_f32_32x32x16_bf16(kf[2],qr[1],C0,0,0,0),   P0[10],P0[11],P0[12],P0[13], pw1[0]=PKW(P0,8), pw1[1]=PKW(P0,10), pw1); \
    VRD(5); SBAR(); GAPA(C1=__builtin_amdgcn_mfma_f32_32x32x16_bf16(kf[3],qr[1],C1,0,0,0),   P0[14],P0[15],P1[0],P1[1],   pw1[2]=PKW(P0,12),pw1[3]=PKW(P0,14), pw1); \
    VRD(2); SBAR(); GAPA(C0=__builtin_amdgcn_mfma_f32_32x32x16_bf16(kf[4],qr[2],C0,0,0,0),   P1[2],P1[3],P1[4],P1[5],     pw2[0]=PKW(P1,0), pw2[1]=PKW(P1,2), pw2); \
    VRD(6); SBAR(); GAPA(C1=__builtin_amdgcn_mfma_f32_32x32x16_bf16(kf[5],qr[2],C1,0,0,0),   P1[6],P1[7],P1[8],P1[9],     pw2[2]=PKW(P1,4), pw2[3]=PKW(P1,6), pw2); \
    VRD(3); SBAR(); GAPA(C0=__builtin_amdgcn_mfma_f32_32x32x16_bf16(kf[6],qr[3],C0,0,0,0),   P1[10],P1[11],P1[12],P1[13], pw3[0]=PKW(P1,8), pw3[1]=PKW(P1,10), pw3); \
    VRD(7); SBAR(); GAPA(C1=__builtin_amdgcn_mfma_f32_32x32x16_bf16(kf[7],qr[3],C1,0,0,0),   P1[14],P1[15],0.f,0.f,       pw3[2]=PKW(P1,12),pw3[3]=PKW(P1,14), pw3); \
    l_reg+=sacc; \
    if(GK){DMA_K((t)+3,sl_cur);} if(GV){DMA_V((t)+1,sl_next);} \
    CMASK(C0,C1,t); \
    if constexpr(!SREF){ float a=MX3(C0[0],C0[1],C1[0]),b=MX3(C0[2],C0[3],C1[1]); a=MX3(a,C1[2],C1[3]); \
      _Pragma("unroll") for(int r=4;r<16;r+=4){a=MX3(a,C0[r],C0[r+1]);b=MX3(b,C0[r+2],C0[r+3]);a=MX3(a,C1[r],C1[r+1]);b=MX3(b,C1[r+2],C1[r+3]);} \
      float rm=__builtin_fmaxf(a,b); { auto rr=__builtin_amdgcn_permlane32_swap(__float_as_uint(rm),__float_as_uint(rm),false,false); rm=__builtin_fmaxf(__uint_as_float(rr[0]),__uint_as_float(rr[1])); } \
      resc=false; \
      if(__builtin_expect(__any(rm>(float)THRL),0)){ const float dl=__builtin_fmaxf(rm,0.f); mhat+=dl; \
        _Pragma("unroll") for(int r=0;r<16;++r){C0[r]-=dl;C1[r]-=dl;} \
        _Pragma("unroll") for(int r=0;r<16;++r)negm[r]=-mhat; asm volatile("":"+v"(negm)); \
        const float f=__builtin_amdgcn_exp2f(-dl); l_reg*=f; if(hi==0)wsf[r32]=f; resc=true; } } \
    SBAR(); \
    GAPB(o[0]=__builtin_amdgcn_mfma_f32_32x32x16_bf16(PAF(0),VFR(0),o[0],0,0,0), C0,0); \
    GAPB(o[1]=__builtin_amdgcn_mfma_f32_32x32x16_bf16(PAF(0),VFR(4),o[1],0,0,0), C0,4); \
    KRD(GL,0); GAPB(o[0]=__builtin_amdgcn_mfma_f32_32x32x16_bf16(PAF(1),VFR(1),o[0],0,0,0), C0,8); \
    KRD(GL,1); GAPB(o[1]=__builtin_amdgcn_mfma_f32_32x32x16_bf16(PAF(1),VFR(5),o[1],0,0,0), C0,12); \
    KRD(GL,2); GAPB(o[0]=__builtin_amdgcn_mfma_f32_32x32x16_bf16(PAF(2),VFR(2),o[0],0,0,0), C1,0); \
    KRD(GL,3); GAPB(o[1]=__builtin_amdgcn_mfma_f32_32x32x16_bf16(PAF(2),VFR(6),o[1],0,0,0), C1,4); \
    GAPB(o[0]=__builtin_amdgcn_mfma_f32_32x32x16_bf16(PAF(3),VFR(3),o[0],0,0,0), C1,8); \
    GAPB(o[1]=__builtin_amdgcn_mfma_f32_32x32x16_bf16(PAF(3),VFR(7),o[1],0,0,0), C1,12); \
    }while(0)
  int t=1;
  #undef CMASK
  #define CMASK(P0,P1,t) do{}while(0)
  for(;t+5<NT;t+=2){
    STEP(pB0,pB1,pA0,pA1,t,true,true,true);     WAIT_BAR(2); RESC(); ROT();
    STEP(pA0,pA1,pB0,pB1,t+1,true,true,true);   WAIT_BAR(2); RESC(); ROT();
  }
  #undef CMASK
  #define CMASK(P0,P1,t) do{}while(0)
  #define ENDW(tt) do{ if((tt)+3<NT){WAIT_BAR(2);} else if((tt)+2<NT){WAIT_BAR(1);} else {WAIT_BAR(0);} }while(0)
  for(;t+1<NT;t+=2){
    STEP(pB0,pB1,pA0,pA1,t,(t+3<NT),(t+1<NT),(t+1<NT));       ENDW(t);   RESC(); ROT();
    STEP(pA0,pA1,pB0,pB1,t+1,(t+4<NT),(t+2<NT),(t+2<NT));     ENDW(t+1); RESC(); ROT();
  }
  STEP(pB0,pB1,pA0,pA1,NT-1,false,false,false); RESC();
  { float sacc=pB0[0]+pB0[1]; _Pragma("unroll") for(int r=2;r<16;++r)sacc+=pB0[r]; _Pragma("unroll") for(int r=0;r<16;++r)sacc+=pB1[r]; l_reg+=sacc;
    pw0=(u32x4){PKW(pB0,0),PKW(pB0,2),PKW(pB0,4),PKW(pB0,6)};pw1=(u32x4){PKW(pB0,8),PKW(pB0,10),PKW(pB0,12),PKW(pB0,14)};pw2=(u32x4){PKW(pB1,0),PKW(pB1,2),PKW(pB1,4),PKW(pB1,6)};pw3=(u32x4){PKW(pB1,8),PKW(pB1,10),PKW(pB1,12),PKW(pB1,14)};
    SBAR(); pv(o,vb0+sl_cur,PAF(0),PAF(1),PAF(2),PAF(3)); }
  #undef PKW
  #undef PAF
  #undef VFR
  #undef PIN
  #undef MX3
  #undef GAPA
  #undef GAPB
  #undef EX
  #undef VRD
  #undef KRD
  #undef STEP
  #undef ENDW
  {auto rr=__builtin_amdgcn_permlane32_swap(__float_as_uint(l_reg),__float_as_uint(l_reg),false,false);l_reg=__uint_as_float(rr[0])+__uint_as_float(rr[1]);}
  if(hi==0)wsf[32+r32]=l_reg;asm volatile("s_waitcnt lgkmcnt(0)":::"memory");
  float rli[16];
  #pragma unroll
  for(int r=0;r<16;++r)rli[r]=__builtin_amdgcn_rcpf(wsf[32+crow(r,hi)]);
  bf16*Ow=O+(rowbase+q0+wid*QBLK)*OP+h*D;
  { bf16*stg=(bf16*)(shm+LDS_OST)+wid*2048;
    #pragma unroll
    for(int r=0;r<16;++r){const int orow=crow(r,hi);
      #pragma unroll
      for(int d0=0;d0<2;++d0)stg[orow*64+d0*32+r32]=__float2bfloat16(o[d0][r]*rli[r]);}
    asm volatile("s_waitcnt lgkmcnt(0)":::"memory");
    #pragma unroll
    for(int i=0;i<4;++i){const int row=i*8+(lane>>3),ch=lane&7; const u32x4 v=*(const u32x4*)(stg+row*64+ch*8); ATTN_STORE16(Ow+(long)row*OP+ch*8,v);} }
  asm volatile("s_waitcnt lgkmcnt(0)\n\ts_barrier":::"memory");
  #undef DMA_K
  #undef DMA_V
  #undef CMASK
  #undef START
  #undef RESC
  #undef ROT
}
constexpr int ATTN_LDS_BYTES=LDS_BYTES;
#undef SBAR
#undef WAIT_BAR
}
constexpr int DMODEL = 1024, NTOK = 131072, NTP = 65536, DFF = 2816, NPROJ = 2304, NBATCH = 24, NLAYER = 2, NMOD = 6144;
constexpr int NWAVES = 8, NTHREADS = 512;
constexpr int LDS_TOTAL = 147456;
constexpr float RMS_EPS = 1e-6f;
constexpr size_t MiB = 1u << 20;
constexpr size_t WS_BAR = 1u << 20, WS_BAR_BYTES = 65536;
constexpr size_t WS_ROT = 0;
constexpr size_t WS_MOD = 2 * MiB;
constexpr size_t WS_W = 4 * MiB;
constexpr size_t W_IN = 0, W_OUT = W_IN + (size_t)NPROJ * 1024 * 2, W_GU = W_OUT + (size_t)1024 * 1024 * 2, W_DN = W_GU + (size_t)2 * DFF * 1024 * 2, W_LAYER = W_DN + (size_t)1024 * DFF * 2;
static_assert(WS_W + 2 * W_LAYER <= 52 * MiB, "weights");
constexpr size_t WS_H = 52 * MiB;
constexpr size_t WS_F = 308 * MiB;
constexpr size_t WS_Q = WS_F, WS_K = WS_Q + 128 * MiB, WS_V = WS_K + 32 * MiB, WS_BG = WS_V + 32 * MiB, WS_CU = WS_BG + 128 * MiB, WS_MODP = WS_CU + 128 * MiB;
constexpr int MOD_KC = 32;
constexpr size_t WS_END = WS_F + (size_t)NTOK * DFF * 2;
static_assert(WS_ROT == pg8::PWS_ROT && WS_Q == pg8::PWS_Q && WS_K == pg8::PWS_K && WS_V == pg8::PWS_V && WS_BG == pg8::PWS_BG && WS_CU == pg8::PWS_CU, "EpiProj offsets");
static_assert(WS_MODP + (size_t)MOD_KC * NLAYER * NBATCH * NMOD * 4 <= WS_END && WS_END <= 1024 * MiB, "d_ws map");

#define LAS __attribute__((address_space(3)))
typedef unsigned short bf16;
typedef unsigned v4u __attribute__((ext_vector_type(4)));
typedef unsigned v2u __attribute__((ext_vector_type(2)));
typedef float f32x4 __attribute__((ext_vector_type(4)));
__device__ __forceinline__ unsigned pk2(float lo, float hi) { return pg8::cvt_pk_bf16(lo, hi); }
__device__ __forceinline__ float wave_sum(float v) {
#pragma unroll
    for (int o = 1; o < 64; o <<= 1) v += __shfl_xor(v, o);
    return v;
}
__device__ __forceinline__ int batch_of_row(int row) { return row < NTP ? (row >> 13) : 8 + ((row - NTP) >> 12); }
__device__ __forceinline__ int team_tile(int m, int x) { return m < 32 ? 32 * x + m : 256 + 32 * x + (m - 32); }

struct Args {
    const float *xp, *xs, *cp, *cs, *w_mod, *b_mod, *g_mix, *w_in, *q_gain, *k_gain, *conv_w, *w_out, *g_ffn, *w_gate, *w_up, *w_down, *g_final;
    float* out; unsigned char* ws; int G; int pad;
};

__device__ __forceinline__ void transpose_item(const float* W, int K, int N, bf16* WT, int k0, int n0, int dst_row0, LAS float* scr, int lane) {
    float wv[32];
#pragma unroll
    for (int i = 0; i < 32; ++i) wv[i] = __builtin_nontemporal_load(W + (size_t)(k0 + 2 * i + (lane >> 5)) * N + n0 + (lane & 31));
#pragma unroll
    for (int i = 0; i < 32; ++i) scr[(2 * i + (lane >> 5)) * 33 + (lane & 31)] = wv[i];
    asm volatile("s_waitcnt lgkmcnt(0)" ::: "memory");
    const int c = lane & 7;
#pragma unroll
    for (int j = 0; j < 4; ++j) { const int n = (lane >> 3) + 8 * j; const LAS float* s = scr + (8 * c) * 33 + n;
        v4u o; o.x = pk2(s[0 * 33], s[1 * 33]); o.y = pk2(s[2 * 33], s[3 * 33]); o.z = pk2(s[4 * 33], s[5 * 33]); o.w = pk2(s[6 * 33], s[7 * 33]);
        *(v4u*)(WT + (size_t)(dst_row0 + n) * K + k0 + 8 * c) = o; }
    asm volatile("s_waitcnt lgkmcnt(0)" ::: "memory");
}
__device__ __forceinline__ int proj_row(int L) {
    if (L < 1280) { const int grp = L >> 6, d = L & 63; return 256 * (grp >> 2) + 128 * (d >> 5) + 32 * (grp & 3) + (d & 31); }
    if (L < 1792) { const int ch = L - 1280; return 256 * (5 + (ch >> 7)) + (ch & 127); }
    const int ch = L - 1792; return 256 * (5 + (ch >> 7)) + 128 + (ch & 127);
}

__device__ __forceinline__ void phase_prologue(const __attribute__((address_space(4))) Args& a, LAS unsigned char* lds, int gw, int NGW, int wave, int lane) {
    unsigned char* ws = a.ws;
    {
        LAS float* scr = (LAS float*)(lds + wave * 16384);
        constexpr int I_IN = 16 * (NPROJ / 32), I_OUT = 16 * 32, I_G = 16 * (DFF / 32), I_D = (DFF / 64) * 32, I_LAYER = I_IN + I_OUT + 2 * I_G + I_D;
        for (int it = gw; it < NLAYER * I_LAYER; it += NGW) {
            const int l = it / I_LAYER; int r = it % I_LAYER; unsigned char* wl = ws + WS_W + l * W_LAYER;
            if (r < I_IN) { const int nb = NPROJ / 32, k0 = 64 * (r / nb), n0 = 32 * (r % nb); transpose_item(a.w_in + (size_t)l * 1024 * NPROJ, 1024, NPROJ, (bf16*)(wl + W_IN), k0, n0, proj_row(n0), scr, lane); continue; } r -= I_IN;
            if (r < I_OUT) { const int k0 = 64 * (r / 32), n0 = 32 * (r % 32); transpose_item(a.w_out + (size_t)l * 1024 * 1024, 1024, 1024, (bf16*)(wl + W_OUT), k0, n0, n0, scr, lane); continue; } r -= I_OUT;
            if (r < I_G) { const int nb = DFF / 32, k0 = 64 * (r / nb), n0 = 32 * (r % nb); transpose_item(a.w_gate + (size_t)l * 1024 * DFF, 1024, DFF, (bf16*)(wl + W_GU), k0, n0, 256 * (n0 >> 7) + (n0 & 127), scr, lane); continue; } r -= I_G;
            if (r < I_G) { const int nb = DFF / 32, k0 = 64 * (r / nb), n0 = 32 * (r % nb); transpose_item(a.w_up + (size_t)l * 1024 * DFF, 1024, DFF, (bf16*)(wl + W_GU), k0, n0, 256 * (n0 >> 7) + 128 + (n0 & 127), scr, lane); continue; } r -= I_G;
            { const int k0 = 64 * (r / 32), n0 = 32 * (r % 32); transpose_item(a.w_down + (size_t)l * DFF * 1024, DFF, 1024, (bf16*)(wl + W_DN), k0, n0, n0, scr, lane); }
        }
    }
    if (blockIdx.x == 0) {
        float* rot = (float*)(ws + WS_ROT);
        for (int i = threadIdx.x; i < 128 * 16; i += NTHREADS) { const int pos = i >> 4, j = i & 15; const float inv = powf(10000.0f, -(float)j / 16.0f); const float ang = (float)pos * inv;
            rot[2 * i] = cosf(ang); rot[2 * i + 1] = sinf(ang); }
    }
    __syncthreads();
    {
        LAS float* sc = (LAS float*)lds;
        for (int i = threadIdx.x; i < NBATCH * 1024; i += NTHREADS) { const float v = i < 8 * 1024 ? a.cp[i] : a.cs[i - 8 * 1024]; sc[i] = v / (1.0f + __expf(-v)); }
        __syncthreads();
        float* modp = (float*)(ws + WS_MODP);
        constexpr int NCG = NMOD / 64, ITEMS = NLAYER * NCG * MOD_KC;
        for (int it = gw; it < ITEMS; it += NGW) {
            const int kc = it % MOD_KC, cgp = (it / MOD_KC) % NCG, l = it / (MOD_KC * NCG);
            const float* wp = a.w_mod + (size_t)l * 1024 * NMOD + (size_t)(kc * 32) * NMOD + cgp * 64 + lane;
            float accb[NBATCH];
#pragma unroll
            for (int b = 0; b < NBATCH; ++b) accb[b] = 0.f;
            float wall[32];
#pragma unroll
            for (int j = 0; j < 32; ++j) wall[j] = __builtin_nontemporal_load(wp + (size_t)j * NMOD);
#pragma unroll
            for (int k4 = 0; k4 < 8; ++k4) {
                float w[4];
#pragma unroll
                for (int j = 0; j < 4; ++j) w[j] = wall[k4 * 4 + j];
#pragma unroll
                for (int b = 0; b < NBATCH; ++b) { const f32x4 s = *(const LAS f32x4*)(sc + b * 1024 + kc * 32 + k4 * 4); accb[b] += (w[0] * s[0] + w[1] * s[1]) + (w[2] * s[2] + w[3] * s[3]); }
            }
            float* o = modp + ((size_t)(kc * NLAYER + l) * NBATCH) * NMOD + cgp * 64 + lane;
#pragma unroll
            for (int b = 0; b < NBATCH; ++b) o[(size_t)b * NMOD] = accb[b];
        }
    }
}
__device__ __forceinline__ void phase_mod_final(const __attribute__((address_space(4))) Args& a) {
    const float* modp = (const float*)(a.ws + WS_MODP); float* mod = (float*)(a.ws + WS_MOD);
    for (int i = blockIdx.x * NTHREADS + threadIdx.x; i < NLAYER * NBATCH * NMOD; i += gridDim.x * NTHREADS) {
        const int n = i % NMOD, l = i / (NBATCH * NMOD); float s = a.b_mod[l * NMOD + n];
#pragma unroll 8
        for (int kc = 0; kc < MOD_KC; ++kc) s += modp[(size_t)kc * NLAYER * NBATCH * NMOD + i];
        mod[i] = s;
    }
}
__device__ __forceinline__ void wave_sum4(float (&s)[4]) {
#pragma unroll
    for (int o = 1; o < 64; o <<= 1) {
#pragma unroll
        for (int i = 0; i < 4; ++i) s[i] += __shfl_xor(s[i], o); }
}
__device__ __forceinline__ void unpack8v(const v4u p, f32x4& a, f32x4& b) {
    a = (f32x4){__uint_as_float(p.x << 16), __uint_as_float(p.x & 0xffff0000u), __uint_as_float(p.y << 16), __uint_as_float(p.y & 0xffff0000u)};
    b = (f32x4){__uint_as_float(p.z << 16), __uint_as_float(p.z & 0xffff0000u), __uint_as_float(p.w << 16), __uint_as_float(p.w & 0xffff0000u)};
}
template <bool IN_BF16>
__device__ __forceinline__ void phase_norm(const float* xa, const float* xb, const bf16* res, const float* g, const float* shift, const float* scale, bf16* H, int x, int wv, int nwv, int lane, int rev) {
    for (int ch0 = wv; ch0 < 1024; ch0 += nwv) {
        const int ch = rev ? 1023 - ch0 : ch0; const int r0 = team_tile(ch >> 4, x) * 256 + (ch & 15) * 16; const int b = batch_of_row(r0); const float* xin = r0 < NTP ? xa : xb;
        f32x4 gs[4], sh[4];
#pragma unroll
        for (int j = 0; j < 4; ++j) { const int c = 8 * lane + 512 * (j >> 1) + 4 * (j & 1); gs[j] = *(const f32x4*)(g + c) * (1.0f + *(const f32x4*)(scale + (size_t)b * NMOD + c)); sh[j] = *(const f32x4*)(shift + (size_t)b * NMOD + c); }
#pragma unroll 1
        for (int r = r0; r < r0 + 16; r += 4) {
            f32x4 v[4][4]; float s[4];
            if constexpr (IN_BF16) {
                v4u p[4][2];
#pragma unroll
                for (int i = 0; i < 4; ++i) { const v4u* xr = (const v4u*)(res + (size_t)(r + i) * 2048) + lane; p[i][0] = xr[0]; p[i][1] = xr[64]; }
#pragma unroll
                for (int i = 0; i < 4; ++i) { unpack8v(p[i][0], v[i][0], v[i][1]); unpack8v(p[i][1], v[i][2], v[i][3]); }
            } else {
#pragma unroll
                for (int i = 0; i < 4; ++i) { const f32x4* xr = (const f32x4*)(xin + (size_t)(r + i) * 1024) + 2 * lane;
                    v[i][0] = __builtin_nontemporal_load(xr); v[i][1] = __builtin_nontemporal_load(xr + 1); v[i][2] = __builtin_nontemporal_load(xr + 128); v[i][3] = __builtin_nontemporal_load(xr + 129); }
            }
#pragma unroll
            for (int i = 0; i < 4; ++i) { s[i] = 0.f;
#pragma unroll
                for (int j = 0; j < 4; ++j) s[i] += (v[i][j][0] * v[i][j][0] + v[i][j][1] * v[i][j][1]) + (v[i][j][2] * v[i][j][2] + v[i][j][3] * v[i][j][3]); }
            wave_sum4(s);
#pragma unroll
            for (int i = 0; i < 4; ++i) { const float rstd = 1.0f / sqrtf(s[i] * (1.0f / 1024.0f) + RMS_EPS);
                v4u* o = (v4u*)(H + (size_t)(r + i) * 1024) + lane;
#pragma unroll
                for (int h = 0; h < 2; ++h) { const f32x4 y0 = v[i][2 * h] * rstd * gs[2 * h] + sh[2 * h], y1 = v[i][2 * h + 1] * rstd * gs[2 * h + 1] + sh[2 * h + 1];
                    v4u w; w.x = pk2(y0[0], y0[1]); w.y = pk2(y0[2], y0[3]); w.z = pk2(y1[0], y1[1]); w.w = pk2(y1[2], y1[3]); o[64 * h] = w; } }
        }
    }
}
__device__ __forceinline__ void phase_final_norm(float* x, const float* g, int tx, int wv, int nwv, int lane) {
    f32x4 gs[4];
#pragma unroll
    for (int j = 0; j < 4; ++j) gs[j] = *(const f32x4*)(g + 8 * lane + 512 * (j >> 1) + 4 * (j & 1));
    for (int st = wv; st < 4096; st += nwv) {
        const int r = team_tile(st >> 6, tx) * 256 + (st & 63) * 4;
        f32x4 v[4][4]; float s[4]; v4u p[4][2];
#pragma unroll
        for (int i = 0; i < 4; ++i) { const v4u* xr = (const v4u*)(x + (size_t)(r + i) * 1024) + lane; p[i][0] = xr[0]; p[i][1] = xr[64]; }
#pragma unroll
        for (int i = 0; i < 4; ++i) { unpack8v(p[i][0], v[i][0], v[i][1]); unpack8v(p[i][1], v[i][2], v[i][3]); }
#pragma unroll
        for (int i = 0; i < 4; ++i) { s[i] = 0.f;
#pragma unroll
            for (int j = 0; j < 4; ++j) s[i] += (v[i][j][0] * v[i][j][0] + v[i][j][1] * v[i][j][1]) + (v[i][j][2] * v[i][j][2] + v[i][j][3] * v[i][j][3]); }
        wave_sum4(s);
#pragma unroll
        for (int i = 0; i < 4; ++i) { const float rstd = 1.0f / sqrtf(s[i] * (1.0f / 1024.0f) + RMS_EPS);
            f32x4* xr = (f32x4*)(x + (size_t)(r + i) * 1024) + 2 * lane;
            __builtin_nontemporal_store(v[i][0] * rstd * gs[0], xr); __builtin_nontemporal_store(v[i][1] * rstd * gs[1], xr + 1);
            __builtin_nontemporal_store(v[i][2] * rstd * gs[2], xr + 128); __builtin_nontemporal_store(v[i][3] * rstd * gs[3], xr + 129); }
    }
}
__device__ __forceinline__ void unpack8(const v4u p, float (&f)[8]) {
#pragma unroll
    for (int i = 0; i < 4; ++i) { f[2 * i] = __uint_as_float(p[i] << 16); f[2 * i + 1] = __uint_as_float(p[i] & 0xffff0000u); }
}
__device__ __forceinline__ void phase_conv(const bf16* Bg, const bf16* CU, const float* cw, bf16* MIX, int x, int wv, int nwv, int lane, int rev) {
    float w0[8], w1[8], w2[8];
#pragma unroll
    for (int i = 0; i < 8; ++i) { w0[i] = cw[8 * lane + i]; w1[i] = cw[512 + 8 * lane + i]; w2[i] = cw[1024 + 8 * lane + i]; }
    const v4u zero = {0u, 0u, 0u, 0u};
    for (int ch0 = wv; ch0 < 2048; ch0 += nwv) {
        const int ch = rev ? 2047 - ch0 : ch0; const int r0 = team_tile(ch >> 5, x) * 256 + (ch & 31) * 8; const int S = r0 < NTP ? 8192 : 4096;
        const v4u* cup = (const v4u*)(CU + (size_t)r0 * 512) + lane;
        const v4u* bgp = (const v4u*)(Bg + (size_t)r0 * 512) + lane;
        v4u cu[10], bg[8];
        cu[0] = ((r0 & (S - 1)) == 0) ? zero : cup[-64];
#pragma unroll
        for (int i = 0; i < 8; ++i) cu[i + 1] = cup[i * 64];
        cu[9] = (((r0 + 8) & (S - 1)) == 0) ? zero : cup[8 * 64];
#pragma unroll
        for (int i = 0; i < 8; ++i) bg[i] = bgp[i * 64];
#pragma unroll
        for (int i = 0; i < 8; ++i) {
            float p[8], c[8], n[8], g[8], o[8]; unpack8(cu[i], p); unpack8(cu[i + 1], c); unpack8(cu[i + 2], n); unpack8(bg[i], g);
#pragma unroll
            for (int k = 0; k < 8; ++k) o[k] = g[k] * (w0[k] * p[k] + w1[k] * c[k] + w2[k] * n[k]);
            v4u w; w.x = pk2(o[0], o[1]); w.y = pk2(o[2], o[3]); w.z = pk2(o[4], o[5]); w.w = pk2(o[6], o[7]);
            *((v4u*)(MIX + (size_t)(r0 + i) * 1024 + 512) + lane) = w;
        }
    }
}
template <bool SREF>
__device__ __forceinline__ void attn_units(float mref, const bf16* Q, const bf16* K, const bf16* V, bf16* MIX, char* lds, int x, int r, int n, int rev) {
    for (int u0 = r; u0 < 512; u0 += n) { const int u = rev ? 511 - u0 : u0;
        long rowbase; int S, h, qb;
        if (u < 256) { rowbase = (long)x * 8192; S = 8192; h = u >> 5; qb = u & 31; }
        else { const int u2 = u - 256, w = u2 & 127; rowbase = NTP + (long)(2 * x + (u2 >> 7)) * 4096; S = 4096; h = w >> 4; qb = w & 15; }
        attn_body::attn_unit<8, SREF>(mref, rowbase, S, h, h >> 2, qb, (const attn_body::bf16*)Q, (const attn_body::bf16*)K, (const attn_body::bf16*)V, (attn_body::bf16*)MIX, lds);
    }
}
__device__ __forceinline__ void phase_attn(const float* qg, const float* kg, const bf16* Q, const bf16* K, const bf16* V, bf16* MIX, char* lds, int x, int r, int n, int lane, int rev) {
    float qm = fabsf(qg[lane]), km = fabsf(kg[lane]);
#pragma unroll
    for (int o = 1; o < 64; o <<= 1) { qm = fmaxf(qm, __shfl_xor(qm, o)); km = fmaxf(km, __shfl_xor(km, o)); }
    const float mref = __builtin_bit_cast(float, __builtin_amdgcn_readfirstlane(__builtin_bit_cast(int, 8.0f * 1.4426950408889634f * 1.02f * qm * km + 0.25f)));
    if (mref <= 40.0f) attn_units<true>(mref, Q, K, V, MIX, lds, x, r, n, rev);
    else attn_units<false>(0.f, Q, K, V, MIX, lds, x, r, n, rev);
}

#define XB_TMO      128
#define XB_XCNT(j)  (256  + 64 * (j))
#define XB_XSUB(j)  (1280 + 64 * (j))
#define XB_XGEN(j)  (2304 + 64 * (j))
#define XB_TOP      3328
#define XB_TOPGEN   3392
#define XCD_BAR_WORDS 3456
#define XB_SPIN_CAP (1u << 18)

__device__ __forceinline__ unsigned xb_ld(unsigned* p)              { return __hip_atomic_load(p, __ATOMIC_RELAXED, __HIP_MEMORY_SCOPE_AGENT); }
__device__ __forceinline__ unsigned xb_add(unsigned* p, unsigned v) { return __hip_atomic_fetch_add(p, v, __ATOMIC_RELAXED, __HIP_MEMORY_SCOPE_AGENT); }
__device__ __forceinline__ unsigned xb_xcc_id() { return (unsigned)__builtin_amdgcn_s_getreg((3 << 11) | 20) & 0xFu; }
#define XB_SPIN(cond, bar) do { unsigned _sp = 0; while (cond) { __builtin_amdgcn_s_sleep(1); \
    if ((++_sp & 255u) == 0u) { if (xb_ld(&(bar)[XB_TMO])) break; if (_sp > XB_SPIN_CAP) { atomicAdd(&(bar)[XB_TMO], 1u); break; } } } } while (0)

struct XcdBarrier {
    unsigned* bar; unsigned x;
    volatile LAS unsigned* st;
};

__device__ __forceinline__ XcdBarrier xcd_barrier_post(unsigned* bar, volatile LAS unsigned* st) {
    XcdBarrier b; b.bar = bar; b.x = xb_xcc_id(); b.st = st;
    if (threadIdx.x == 0) (void)xb_add(&bar[XB_XCNT(b.x)], 1u);
    return b;
}
__device__ __forceinline__ void xcd_barrier_complete(unsigned* bar, unsigned x, unsigned& nloc, unsigned& nx) {
    const unsigned G = gridDim.x * gridDim.y * gridDim.z;
    unsigned sum, cnt, mine, sp = 0u;
    for (;;) {
        sum = 0u; cnt = 0u; mine = 0u;
#pragma unroll
        for (unsigned j = 0; j < 16; ++j) { const unsigned c = xb_ld(&bar[XB_XCNT(j)]); sum += c; cnt += (c > 0u) ? 1u : 0u; mine = (j == x) ? c : mine; }
        if (sum == G) break;
        __builtin_amdgcn_s_sleep(1);
        if ((++sp & 255u) == 0u) { if (xb_ld(&bar[XB_TMO])) break; if (sp > XB_SPIN_CAP) { atomicAdd(&bar[XB_TMO], 1u); break; } }
    }
    nloc = mine > 0u ? mine : 1u; nx = cnt > 0u ? cnt : 1u;
}

__device__ __forceinline__ void xcd_barrier(const XcdBarrier& b) {
    asm volatile("s_waitcnt vmcnt(0)" ::: "memory");
    __syncthreads();
    if (threadIdx.x == 0) {
        unsigned* bar = b.bar;
        __builtin_amdgcn_s_waitcnt(0);
        unsigned nloc = b.st[0], nx = b.st[1];
        if (nloc == 0u) { xcd_barrier_complete(bar, b.x, nloc, nx); b.st[0] = nloc; b.st[1] = nx; }
        const unsigned old = xb_add(&bar[XB_XSUB(b.x)], 1u);
        const unsigned gen = old / nloc;
        if (old + 1u == (gen + 1u) * nloc) {
            __builtin_amdgcn_fence(__ATOMIC_RELEASE, "agent");
            asm volatile("s_waitcnt vmcnt(0)" ::: "memory");
            const unsigned og = xb_add(&bar[XB_TOP], 1u);
            const unsigned tg = og / nx;
            if (og + 1u == (tg + 1u) * nx) xb_add(&bar[XB_TOPGEN], 1u);
            else XB_SPIN(xb_ld(&bar[XB_TOPGEN]) == tg, bar);
            __builtin_amdgcn_fence(__ATOMIC_ACQUIRE, "agent");
            xb_add(&bar[XB_XGEN(b.x)], 1u);
            asm volatile("s_waitcnt vmcnt(0)" ::: "memory");
        } else {
            XB_SPIN(xb_ld(&bar[XB_XGEN(b.x)]) == gen, bar);
            __builtin_amdgcn_fence(__ATOMIC_ACQUIRE, "agent");
            asm volatile("s_waitcnt vmcnt(0)" ::: "memory");
        }
    }
    __syncthreads();
}


typedef __attribute__((address_space(4))) const Args* KArgs;
__device__ __forceinline__ KArgs kargs() { KArgs p = (KArgs)__builtin_amdgcn_kernarg_segment_ptr(); asm volatile("" : "+s"(p)); return p; }
struct TeamOrder {
    int nN, x, r, n, rev;
    __device__ __forceinline__ bool next(int i, pg8::Unit& u) const {
        const int L = i * n + r; if (L >= 64 * nN) return false;
        const int nig = 8 * nN, gid = L / nig, w = L % nig; int m = gid * 8 + (w & 7); if (rev) m = 63 - m;
        u.pm = team_tile(m, x); u.pn = w >> 3; return true;
    }
    __device__ __forceinline__ void a_ready(const pg8::Unit&) const {}
    __device__ __forceinline__ void done(const pg8::Unit&) const {}
};
#define TB_WORD(x) (4096 + 128 * (x))
#define ID_WORD(b) (8192 + (b))
__device__ __forceinline__ void team_barrier(unsigned* bar, int x, unsigned n) {
    asm volatile("s_waitcnt vmcnt(0)" ::: "memory");
    __syncthreads();
    if (threadIdx.x == 0) {
        __builtin_amdgcn_s_waitcnt(0);
        unsigned* tb = bar + TB_WORD(x);
        const unsigned old = xb_add(&tb[0], 1u), gen = old / n;
        if (old + 1u == (gen + 1u) * n) xb_add(&tb[64], 1u);
        else XB_SPIN(xb_ld(&tb[64]) == gen, bar);
        __builtin_amdgcn_fence(__ATOMIC_ACQUIRE, "agent");
        asm volatile("s_waitcnt vmcnt(0)" ::: "memory");
    }
    __syncthreads();
}
#ifndef PH
#define PH 0xffff
#endif
#ifndef DBL
#define DBL 0
#endif
#define REP(bit) _Pragma("unroll 1") for (int rep_ = 0; rep_ < (((DBL) & (bit)) ? 2 : 1); ++rep_)
__global__ void __launch_bounds__(NTHREADS, 2) fwd_megakernel(Args a_unused) {
    extern __shared__ __attribute__((aligned(16))) unsigned char lds_raw[];
    cg::grid_group grid = cg::this_grid();
    volatile LAS unsigned* const bst = (volatile LAS unsigned*)((LAS unsigned char*)lds_raw + 131072 + 64);
    if (threadIdx.x < 3) bst[threadIdx.x] = 0u;
    __syncthreads();
    (void)xcd_barrier_post((unsigned*)(kargs()->ws + WS_BAR), bst);
    if (threadIdx.x == 0) ((unsigned*)(kargs()->ws + WS_BAR))[ID_WORD(blockIdx.x)] = 1u + xb_xcc_id();
#define GSYNC() do { XcdBarrier xb_; xb_.bar = (unsigned*)(kargs()->ws + WS_BAR); xb_.x = xb_xcc_id(); xb_.st = (volatile LAS unsigned*)((LAS unsigned char*)lds_raw + 131072 + 64); xcd_barrier(xb_); } while (0)
#define TEAM_OK() (((volatile LAS unsigned*)((LAS unsigned char*)lds_raw + 131072 + 64))[2] != 0u)
#define TSYNC() do { if (TEAM_OK()) team_barrier((unsigned*)(kargs()->ws + WS_BAR), (int)(blockIdx.x & 7), gridDim.x >> 3); else GSYNC(); } while (0)
#define LDSP ((LAS unsigned char*)lds_raw)
#define FRAME() const KArgs A = kargs(); int tid_l = threadIdx.x; asm volatile("" : "+v"(tid_l)); const int lane = tid_l & 63, wave = __builtin_amdgcn_readfirstlane(tid_l >> 6); const int G = gridDim.x, bx = blockIdx.x; \
    const int vcu = (G % 8 == 0) ? (bx % 8) * (G / 8) + bx / 8 : bx; const int gw = vcu * NWAVES + wave, NGW = G * NWAVES; unsigned char* const ws = A->ws; const int tx = bx & 7, tr = bx >> 3, tn = G >> 3, wv = tr * NWAVES + wave, nwv = tn * NWAVES; (void)lane; (void)gw; (void)NGW; (void)ws; (void)vcu; (void)tx; (void)tr; (void)tn; (void)wv; (void)nwv
#define LAYER() const float* const modl = (const float*)(ws + WS_MOD) + (size_t)l * NBATCH * NMOD; unsigned char* const wl = ws + WS_W + l * W_LAYER; (void)modl; (void)wl
#if PH & 1
    REP(1)
    { FRAME(); phase_prologue(*A, LDSP, gw, NGW, wave, lane); __syncthreads(); }
#endif
    grid.sync();
    {
        const unsigned* ids = (const unsigned*)(kargs()->ws + WS_BAR) + ID_WORD(0); const int G_ = gridDim.x; int ok = (G_ % 8 == 0) && (G_ <= NTHREADS);
        if ((int)threadIdx.x < G_ && ok) ok = __hip_atomic_load(ids + threadIdx.x, __ATOMIC_RELAXED, __HIP_MEMORY_SCOPE_AGENT) == __hip_atomic_load(ids + (threadIdx.x & 7), __ATOMIC_RELAXED, __HIP_MEMORY_SCOPE_AGENT);
        ok = __syncthreads_and(ok);
        if (threadIdx.x == 0) ((volatile LAS unsigned*)((LAS unsigned char*)lds_raw + 131072 + 64))[2] = ok ? 1u : 0u;
        __syncthreads();
    }
#if PH & 2
    { FRAME(); phase_mod_final(*A); }
#endif
    GSYNC();
#pragma unroll 1
    for (int l = 0; l < NLAYER; ++l) {
#if PH & 4
        REP(4)
        { FRAME(); LAYER();
          if (l == 0) phase_norm<false>(A->xp, A->xs - (size_t)NTP * 1024, nullptr, A->g_mix + l * 1024, modl + 0 * 1024, modl + 1 * 1024, (bf16*)(ws + WS_H), tx, wv, nwv, lane, (7 * l + 0) & 1);
          else phase_norm<true>(nullptr, nullptr, (const bf16*)A->out, A->g_mix + l * 1024, modl + 0 * 1024, modl + 1 * 1024, (bf16*)(ws + WS_H), tx, wv, nwv, lane, (7 * l + 0) & 1); }
#endif
        TSYNC();
#if PH & 8
        REP(8)
        { FRAME(); LAYER(); pg8::Gemm g{(const bf16*)(ws + WS_H), (const bf16*)(wl + W_IN), NTOK, NPROJ, 1024}; const TeamOrder S{NPROJ / 256, tx, tr, tn, (7 * l + 1) & 1};
          pg8::EpiProj E{ws, A->q_gain + l * 64, A->k_gain + l * 64};
          pg8::gemm_phase<pg8::EpiProj, TeamOrder, true, true>(LDSP, g, S, E); }
#endif
        TSYNC();
#if PH & 16
        REP(16)
        { FRAME(); phase_attn(A->q_gain + l * 64, A->k_gain + l * 64, (const bf16*)(ws + WS_Q), (const bf16*)(ws + WS_K), (const bf16*)(ws + WS_V), (bf16*)(ws + WS_H), (char*)lds_raw, tx, tr, tn, lane, (7 * l + 2) & 1); }
#endif
#if PH & 32
        REP(32)
        { FRAME(); phase_conv((const bf16*)(ws + WS_BG), (const bf16*)(ws + WS_CU), A->conv_w + l * 3 * 512, (bf16*)(ws + WS_H), tx, wv, nwv, lane, (7 * l + 2) & 1); }
#endif
        TSYNC();
#if PH & 64
        { FRAME(); LAYER();
          pg8::Gemm g{(const bf16*)(ws + WS_H), (const bf16*)(wl + W_OUT), NTOK, 1024, 1024}; const TeamOrder S{4, tx, tr, tn, (7 * l + 3) & 1};
          pg8::EpiResid E{A->xp, A->xs - (size_t)NTP * 1024, (bf16*)A->out, modl + 2 * 1024, l == 0 ? 1 : 0};
          pg8::gemm_phase<pg8::EpiResid, TeamOrder, true, true>(LDSP, g, S, E); }
#endif
        TSYNC();
#if PH & 128
        REP(128)
        { FRAME(); LAYER(); phase_norm<true>(nullptr, nullptr, (const bf16*)A->out, A->g_ffn + l * 1024, modl + 3 * 1024, modl + 4 * 1024, (bf16*)(ws + WS_H), tx, wv, nwv, lane, (7 * l + 4) & 1); }
#endif
        GSYNC();
#if PH & 256
        REP(256)
        { FRAME(); LAYER(); pg8::Gemm g{(const bf16*)(ws + WS_H), (const bf16*)(wl + W_GU), NTOK, 2 * DFF, 1024}; const TeamOrder S{2 * DFF / 256, tx, tr, tn, (7 * l + 5) & 1};
          pg8::EpiSwiglu E{(bf16*)(ws + WS_F)};
          pg8::gemm_phase<pg8::EpiSwiglu, TeamOrder, true, true>(LDSP, g, S, E); }
#endif
        TSYNC();
#if PH & 512
        { FRAME(); LAYER(); pg8::Gemm g{(const bf16*)(ws + WS_F), (const bf16*)(wl + W_DN), NTOK, 1024, DFF}; const TeamOrder S{4, tx, tr, tn, (7 * l + 6) & 1};
          pg8::EpiResid E{nullptr, nullptr, (bf16*)A->out, modl + 5 * 1024, 0};
          pg8::gemm_phase<pg8::EpiResid, TeamOrder, true, true>(LDSP, g, S, E); }
#endif
        GSYNC();
    }
#if PH & 1024
    { FRAME(); phase_final_norm(A->out, A->g_final, tx, wv, nwv, lane); }
#endif
}

extern "C" void kernel_launch(void* const* d_in, const int* in_sizes, int n_in, void* d_out, int out_size, void* d_ws, size_t ws_size, hipStream_t stream) {
    static int grid = 0;
    if (grid == 0) {
        if (n_in != 17 || out_size != NTOK * 1024 || ws_size < WS_END) { fprintf(stderr, "kernel_launch: unexpected problem (n_in %d, out %d, ws %zu, need %zu)\n", n_in, out_size, ws_size, (size_t)WS_END); grid = -1; return; }
        int dev = 0, cus = 0, per_cu = 0;
        hipGetDevice(&dev); hipDeviceGetAttribute(&cus, hipDeviceAttributeMultiprocessorCount, dev);
        if (hipFuncSetAttribute((const void*)fwd_megakernel, hipFuncAttributeMaxDynamicSharedMemorySize, LDS_TOTAL) != hipSuccess) { fprintf(stderr, "kernel_launch: hipFuncSetAttribute failed\n"); grid = -1; return; }
        if (hipOccupancyMaxActiveBlocksPerMultiprocessor(&per_cu, (const void*)fwd_megakernel, NTHREADS, LDS_TOTAL) != hipSuccess || per_cu < 1) { fprintf(stderr, "kernel_launch: occupancy query failed (%d)\n", per_cu); (void)hipGetLastError(); per_cu = 1; }
        grid = cus * per_cu;
        if (grid > 256) grid = 256;
        if (grid % 8 != 0 || grid < 8) { fprintf(stderr, "kernel_launch: grid %d is not a multiple of 8 (the layer loop is organised in 8 teams)\n", grid); grid = -1; return; }
        fprintf(stderr, "kernel_launch: grid %d (cus %d, per_cu %d), ws %zu\n", grid, cus, per_cu, ws_size);
    }
    if (grid < 0) return;
    Args a{};
    a.xp = (const float*)d_in[0]; a.xs = (const float*)d_in[1]; a.cp = (const float*)d_in[2]; a.cs = (const float*)d_in[3];
    a.w_mod = (const float*)d_in[4]; a.b_mod = (const float*)d_in[5]; a.g_mix = (const float*)d_in[6]; a.w_in = (const float*)d_in[7];
    a.q_gain = (const float*)d_in[8]; a.k_gain = (const float*)d_in[9]; a.conv_w = (const float*)d_in[10]; a.w_out = (const float*)d_in[11];
    a.g_ffn = (const float*)d_in[12]; a.w_gate = (const float*)d_in[13]; a.w_up = (const float*)d_in[14]; a.w_down = (const float*)d_in[15]; a.g_final = (const float*)d_in[16];
    a.out = (float*)d_out; a.ws = (unsigned char*)d_ws; a.G = grid; a.pad = 0;
    if (hipMemsetAsync((char*)d_ws + WS_BAR, 0, WS_BAR_BYTES, stream) != hipSuccess) { fprintf(stderr, "kernel_launch: memset failed\n"); return; }
    void* args[] = {&a};
    hipError_t e = hipLaunchCooperativeKernel((const void*)fwd_megakernel, dim3(grid), dim3(NTHREADS), args, LDS_TOTAL, stream);
    if (e != hipSuccess) fprintf(stderr, "kernel_launch: cooperative launch failed: %s (grid %d)\n", hipGetErrorString(e), grid);
}
```
